# Optimizing an MI355X kernel written in HIP

```python
import math
import jax, jax.numpy as jnp
from jax import lax
import numpy as np

D_MODEL = 2048
BATCH = 8
SEQ = 2048
DEPTH = 4

N_MIXERS = 2
HEAD_DIM = 128
ROPE_THETA = 10000.0
NORM_EPS = 1e-6
D_FF = 4 * D_MODEL
Q_BLOCK = 128
NEG = -1e30
BIG = 1e30

NSA_HEADS = D_MODEL // HEAD_DIM
NSA_KV_HEADS = 4
NSA_GROUP = NSA_HEADS // NSA_KV_HEADS
CMP_BLOCK = 32
CMP_STRIDE = 16
CMP_HIDDEN = 2 * HEAD_DIM
SLC_BLOCK = 64
SLC_TOPN = 16
SLC_QCHUNK = 64
WIN = 512
NSA_IN = NSA_HEADS * HEAD_DIM + 6 * NSA_KV_HEADS * HEAD_DIM + 3 * NSA_HEADS

DIFF_HEADS = D_MODEL // (2 * HEAD_DIM)
DIFF_IN = 3 * DIFF_HEADS * 2 * HEAD_DIM

kernel_name = "hybrid_nsa_diffattn_sqrelu_adaln"


def rms_norm(x, g):
    xf = x.astype(jnp.float32)
    y = xf * lax.rsqrt(jnp.mean(xf * xf, axis=-1, keepdims=True) + NORM_EPS)
    return (y * g.astype(jnp.float32)).astype(x.dtype)


def rope(x, pos):
    half = x.shape[-1] // 2
    inv = ROPE_THETA ** (-jnp.arange(half, dtype=jnp.float32) / half)
    ang = pos.astype(jnp.float32)[..., None] * inv
    cos = jnp.cos(ang)[:, :, None, :]
    sin = jnp.sin(ang)[:, :, None, :]
    xf = x.astype(jnp.float32)
    x1, x2 = xf[..., :half], xf[..., half:]
    return jnp.concatenate([x1 * cos - x2 * sin, x2 * cos + x1 * sin], axis=-1).astype(x.dtype)


def _compress(blocks, pos_emb, w1, w2):
    hid = jax.nn.silu(jnp.einsum('bnlgd,ldf->bngf', blocks + pos_emb[None, None, :, None, :], w1))
    return jnp.einsum('bngf,fd->bngd', hid, w2)


def _cmp_to_slc_map(n_cmp, n_slc):
    cs = CMP_STRIDE * np.arange(n_cmp)[:, None]
    ss = SLC_BLOCK * np.arange(n_slc)[None, :]
    ov = np.minimum(cs + CMP_BLOCK, ss + SLC_BLOCK) - np.maximum(cs, ss)
    return (np.clip(ov, 0, None) / CMP_STRIDE).astype(np.float32)


def _window_branch(qg, k, v, scale):
    B, T, G, R, dh = qg.shape
    nb = T // Q_BLOCK
    span = WIN + Q_BLOCK
    kp = jnp.pad(k, ((0, 0), (WIN, 0), (0, 0), (0, 0)))
    vp = jnp.pad(v, ((0, 0), (WIN, 0), (0, 0), (0, 0)))

    def blk(n):
        start = n * Q_BLOCK
        qb = lax.dynamic_slice_in_dim(qg, start, Q_BLOCK, axis=1)
        kb = lax.dynamic_slice_in_dim(kp, start, span, axis=1)
        vb = lax.dynamic_slice_in_dim(vp, start, span, axis=1)
        q_tok = start + jnp.arange(Q_BLOCK)
        k_tok = start - WIN + jnp.arange(span)
        rel = q_tok[:, None] - k_tok[None, :]
        mask = (rel >= 0) & (rel < WIN) & (k_tok[None, :] >= 0)
        s = jnp.einsum('bqgrd,bkgd->bqgrk', qb, kb, preferred_element_type=jnp.float32) * scale
        p = jax.nn.softmax(jnp.where(mask[None, :, None, None, :], s, NEG), axis=-1)
        return jnp.einsum('bqgrk,bkgd->bqgrd', p.astype(vb.dtype), vb)

    o = lax.map(blk, jnp.arange(nb))
    return jnp.moveaxis(o, 0, 1).reshape(B, T, G, R, dh)


def _select_branch(qg, k, v, idx, scale):
    B, T, G, R, dh = qg.shape
    ns = T // SLC_BLOCK
    nsel = idx.shape[-1]
    nc = T // SLC_QCHUNK
    k_blk = k.reshape(B, ns, SLC_BLOCK, G, dh).transpose(0, 3, 1, 2, 4)
    v_blk = v.reshape(B, ns, SLC_BLOCK, G, dh).transpose(0, 3, 1, 2, 4)
    g_ar = jnp.arange(G)[None, :, None]
    qc = qg.reshape(B * nc, SLC_QCHUNK, G, R, dh)
    ic = idx.reshape(B * nc, SLC_QCHUNK, G, nsel)
    bid = jnp.repeat(jnp.arange(B), nc)
    cid = jnp.tile(jnp.arange(nc), B)

    def step(args):
        qb, ib, b, ci = args
        kg = k_blk[b][g_ar, ib]
        vg = v_blk[b][g_ar, ib]
        s = jnp.einsum('qgrd,qgnld->qgrnl', qb, kg, preferred_element_type=jnp.float32) * scale
        key_tok = ib[..., None] * SLC_BLOCK + jnp.arange(SLC_BLOCK)
        q_tok = ci * SLC_QCHUNK + jnp.arange(SLC_QCHUNK)
        mask = key_tok <= q_tok[:, None, None, None]
        p = jax.nn.softmax(jnp.where(mask[:, :, None], s, NEG), axis=(-2, -1))
        return jnp.einsum('qgrnl,qgnld->qgrd', p.astype(vg.dtype), vg)

    o = lax.map(step, (qc, ic, bid, cid))
    return o.reshape(B, T, G, R, dh)


def nsa_mixer(h, pos, w_in, w_out, q_g, k_g, cmp_pos, cmp_w1, cmp_w2):
    B, T, _ = h.shape
    H, G, R, dh = NSA_HEADS, NSA_KV_HEADS, NSA_GROUP, HEAD_DIM
    scale = dh ** -0.5
    sizes = [H * dh] + [G * dh] * 6
    splits = [int(s) for s in np.cumsum(sizes)]
    q, kc, vc, ks, vs, kw, vw, gates = jnp.split(h @ w_in, splits, axis=-1)
    q = rope(rms_norm(q.reshape(B, T, H, dh), q_g), pos)
    qg = q.reshape(B, T, G, R, dh)

    n_cmp = (T - CMP_BLOCK) // CMP_STRIDE + 1
    blk_idx = CMP_STRIDE * np.arange(n_cmp)[:, None] + np.arange(CMP_BLOCK)[None, :]
    kc = kc.reshape(B, T, G, dh)
    vc = vc.reshape(B, T, G, dh)
    k_cmp = _compress(kc[:, blk_idx], cmp_pos[0], cmp_w1[0], cmp_w2[0])
    v_cmp = _compress(vc[:, blk_idx], cmp_pos[1], cmp_w1[1], cmp_w2[1])
    k_cmp = rope(rms_norm(k_cmp, k_g[0]), pos[:, blk_idx[:, -1]])
    cmp_end = jnp.asarray(blk_idx[:, -1])
    cmask = cmp_end[None, :] <= jnp.arange(T)[:, None]
    cmask5 = cmask[None, :, None, None, :]
    s = jnp.einsum('btgrd,bngd->btgrn', qg, k_cmp, preferred_element_type=jnp.float32) * scale
    p_cmp = jnp.where(cmask5, jax.nn.softmax(jnp.where(cmask5, s, NEG), axis=-1), 0.0)
    o_cmp = jnp.einsum('btgrn,bngd->btgrd', p_cmp.astype(v_cmp.dtype), v_cmp)

    n_slc = T // SLC_BLOCK
    n_sel = min(SLC_TOPN, n_slc)
    imp = jnp.einsum('btgn,ns->btgs', p_cmp.sum(axis=3), jnp.asarray(_cmp_to_slc_map(n_cmp, n_slc)))
    t_blk = (jnp.arange(T) // SLC_BLOCK)[:, None]
    s_ids = jnp.arange(n_slc)[None, :]
    valid = (s_ids <= t_blk)[None, :, None, :]
    forced = ((s_ids == 0) | (s_ids == t_blk) | (s_ids == t_blk - 1))[None, :, None, :]
    imp = jnp.where(forced, BIG, jnp.where(valid, imp, NEG))
    _, sel_idx = lax.top_k(imp, n_sel)

    ks = rope(rms_norm(ks.reshape(B, T, G, dh), k_g[1]), pos)
    o_slc = _select_branch(qg, ks, vs.reshape(B, T, G, dh), sel_idx, scale)

    kw = rope(rms_norm(kw.reshape(B, T, G, dh), k_g[2]), pos)
    o_win = _window_branch(qg, kw, vw.reshape(B, T, G, dh), scale)

    g = jax.nn.sigmoid(gates.astype(jnp.float32)).astype(h.dtype).reshape(B, T, 3, G, R, 1)
    o = g[:, :, 0] * o_cmp + g[:, :, 1] * o_slc + g[:, :, 2] * o_win
    return o.reshape(B, T, H * dh) @ w_out


def diff_mixer(h, pos, w_in, w_out, q_g, k_g, lam_p, sub_g, lam_init):
    B, T, _ = h.shape
    H, dh = DIFF_HEADS, HEAD_DIM
    scale = dh ** -0.5
    q, k, v = jnp.split(h @ w_in, 3, axis=-1)
    q = rope(rms_norm(q.reshape(B, T, 2 * H, dh), q_g), pos).reshape(B, T, H, 2, dh)
    k = rope(rms_norm(k.reshape(B, T, 2 * H, dh), k_g), pos).reshape(B, T, H, 2, dh)
    v = v.reshape(B, T, H, 2 * dh)
    lp = lam_p.astype(jnp.float32)
    lam = jnp.exp(jnp.sum(lp[0] * lp[1])) - jnp.exp(jnp.sum(lp[2] * lp[3])) + lam_init
    k_tok = jnp.arange(T)

    def blk(n):
        start = n * Q_BLOCK
        qb = lax.dynamic_slice_in_dim(q, start, Q_BLOCK, axis=1)
        s = jnp.einsum('bqhcd,bkhcd->bhcqk', qb, k, preferred_element_type=jnp.float32) * scale
        mask = k_tok[None, :] <= (start + jnp.arange(Q_BLOCK))[:, None]
        p = jax.nn.softmax(jnp.where(mask, s, NEG), axis=-1)
        a = p[:, :, 0] - lam * p[:, :, 1]
        return jnp.einsum('bhqk,bkhe->bqhe', a.astype(v.dtype), v)

    o = lax.map(blk, jnp.arange(T // Q_BLOCK))
    o = jnp.moveaxis(o, 0, 1).reshape(B, T, H, 2 * dh)
    o = rms_norm(o, sub_g) * (1.0 - lam_init)
    return o.reshape(B, T, H * 2 * dh) @ w_out


def sqrelu_mlp(h, w1, w2):
    return jnp.square(jax.nn.relu(h @ w1)) @ w2


def setup_inputs(seed: int = 0) -> dict:
    key = jax.random.key(seed)
    ks = jax.random.split(key, 24)
    f32 = jnp.float32
    D, L = D_MODEL, DEPTH
    n_nsa = (DEPTH + 1) // 2
    n_diff = DEPTH // 2

    def nrm(k, shape, s):
        return jax.random.normal(k, shape, f32) * s

    x = nrm(ks[0], (BATCH, SEQ, D), 1.0)
    c = nrm(ks[1], (BATCH, D), 1.0)
    positions = (jax.random.randint(ks[2], (BATCH, 1), 0, 1024, dtype=jnp.int32)
                 + jnp.arange(SEQ, dtype=jnp.int32)[None, :])
    return {
        "x": x,
        "c": c,
        "positions": positions,
        "ada_w": nrm(ks[3], (L, D, 6 * D), 0.5 * D ** -0.5),
        "ada_b": nrm(ks[4], (L, 6 * D), 0.01),
        "attn_norm_g": 1.0 + nrm(ks[5], (L, D), 0.02),
        "mlp_norm_g": 1.0 + nrm(ks[6], (L, D), 0.02),
        "mlp_w1": nrm(ks[7], (L, D, D_FF), D ** -0.5),
        "mlp_w2": nrm(ks[8], (L, D_FF, D), D_FF ** -0.5),
        "nsa_w_in": nrm(ks[9], (n_nsa, D, NSA_IN), D ** -0.5),
        "nsa_w_out": nrm(ks[10], (n_nsa, NSA_HEADS * HEAD_DIM, D), (NSA_HEADS * HEAD_DIM) ** -0.5),
        "nsa_q_norm": 1.0 + nrm(ks[11], (n_nsa, HEAD_DIM), 0.02),
        "nsa_k_norm": 1.0 + nrm(ks[12], (n_nsa, 3, HEAD_DIM), 0.02),
        "nsa_cmp_pos": nrm(ks[13], (n_nsa, 2, CMP_BLOCK, HEAD_DIM), 0.1),
        "nsa_cmp_w1": nrm(ks[14], (n_nsa, 2, CMP_BLOCK, HEAD_DIM, CMP_HIDDEN), (CMP_BLOCK * HEAD_DIM) ** -0.5),
        "nsa_cmp_w2": nrm(ks[15], (n_nsa, 2, CMP_HIDDEN, HEAD_DIM), CMP_HIDDEN ** -0.5),
        "diff_w_in": nrm(ks[16], (n_diff, D, DIFF_IN), D ** -0.5),
        "diff_w_out": nrm(ks[17], (n_diff, DIFF_HEADS * 2 * HEAD_DIM, D), (DIFF_HEADS * 2 * HEAD_DIM) ** -0.5),
        "diff_q_norm": 1.0 + nrm(ks[18], (n_diff, HEAD_DIM), 0.02),
        "diff_k_norm": 1.0 + nrm(ks[19], (n_diff, HEAD_DIM), 0.02),
        "diff_lambda": nrm(ks[20], (n_diff, 4, HEAD_DIM), 0.1),
        "diff_sub_norm": 1.0 + nrm(ks[21], (n_diff, 2 * HEAD_DIM), 0.02),
    }


def reference(x, c, positions, ada_w, ada_b, attn_norm_g, mlp_norm_g, mlp_w1, mlp_w2,
              nsa_w_in, nsa_w_out, nsa_q_norm, nsa_k_norm, nsa_cmp_pos, nsa_cmp_w1, nsa_cmp_w2,
              diff_w_in, diff_w_out, diff_q_norm, diff_k_norm, diff_lambda, diff_sub_norm):
    mod_all = jnp.einsum('bd,lde->lbe', jax.nn.silu(c), ada_w) + ada_b[:, None, :]
    for i in range(DEPTH):
        sh1, sc1, g1, sh2, sc2, g2 = jnp.split(mod_all[i][:, None, :], 6, axis=-1)
        h = rms_norm(x, attn_norm_g[i]) * (1.0 + sc1) + sh1
        j = i // N_MIXERS
        if i % N_MIXERS == 0:
            y = nsa_mixer(h, positions, nsa_w_in[j], nsa_w_out[j], nsa_q_norm[j], nsa_k_norm[j],
                          nsa_cmp_pos[j], nsa_cmp_w1[j], nsa_cmp_w2[j])
        else:
            lam_init = 0.8 - 0.6 * math.exp(-0.3 * i)
            y = diff_mixer(h, positions, diff_w_in[j], diff_w_out[j], diff_q_norm[j], diff_k_norm[j],
                           diff_lambda[j], diff_sub_norm[j], lam_init)
        x = x + g1 * y
        h = rms_norm(x, mlp_norm_g[i]) * (1.0 + sc2) + sh2
        x = x + g2 * sqrelu_mlp(h, mlp_w1[i], mlp_w2[i])
    return x
```

```cpp
#include <hip/hip_runtime.h>
#include <cstdio>
#include <cstdint>
#ifndef MK_N_LAUNCHES
#define MK_N_LAUNCHES 0
#endif
#ifndef MK_DIS
#define MK_DIS 0
#endif
#define EN(bit) (!((MK_DIS >> (bit)) & 1))

__device__ __forceinline__ int opaque_tid() { int t = threadIdx.x; asm volatile("" : "+v"(t)); return t; }
__device__ __forceinline__ int opaque_bid() { int b = blockIdx.x; asm volatile("" : "+s"(b)); return b; }
namespace pg8 {
#define PG8_LAS __attribute__((address_space(3)))
typedef unsigned short bf16_t;
typedef short bf16x8 __attribute__((ext_vector_type(8)));
typedef float f32x4 __attribute__((ext_vector_type(4)));
typedef unsigned u32x4 __attribute__((ext_vector_type(4)));
constexpr int BM = 256, BK = 64, HALF = 128, HTB = HALF * BK * 2  , STAGE_BYTES = 8 * HTB, NXCD = 8, WGM = 8;

__host__ __device__ __forceinline__ int lds_byte(int r, int c) { const int st = (r >> 4) * 2 + (c >> 5), rr = r & 15, cc = c & 31, ob = rr * 64 + cc * 2; return st * 1024 + (ob ^ (((ob >> 9) & 1) << 5)); }
__host__ __device__ __forceinline__ void stage_rc(int b, int& R, int& C) { const int st = b / 1024, sb = b % 1024, swz = sb ^ (((sb >> 9) & 1) << 5); R = (st >> 1) * 16 + swz / 64; C = (st & 1) * 32 + (swz % 64) / 2; }
__host__ __device__ __forceinline__ int perm32(int rho) { const int n = rho >> 4, i = rho & 15; return 8 * (i >> 2) + 4 * n + (i & 3); }

struct Unit { int pm, pn; };
struct Gemm { const bf16_t* A; const bf16_t* Bt; int M, N, K; };

struct StaticOrder {
    int nM, nN, nwg, G, c;
    __host__ __device__ void init(int M, int N, int G_, int c_) { nM = M / BM; nN = N / BM; nwg = nM * nN; G = G_; c = c_; }
    __host__ __device__ bool next(int i, Unit& u) const {
        const long L = (long)i * G + c; if (L >= nwg) return false;
        int wgid = (int)L; { const int q = nwg / NXCD, r = nwg % NXCD, xcd = wgid % NXCD, off = wgid / NXCD; wgid = (xcd < r ? xcd * (q + 1) : r * (q + 1) + (xcd - r) * q) + off; }
        const int nig = WGM * nN, gid = wgid / nig, fm = gid * WGM, gsz = (nM - fm) < WGM ? (nM - fm) : WGM;
        u.pm = fm + ((wgid % nig) % gsz); u.pn = (wgid % nig) / gsz; return true;
    }
    __device__ __forceinline__ void a_ready(const Unit&) const {}
    __device__ __forceinline__ void done(const Unit&) const {}
};
__device__ __forceinline__ unsigned cvt_pk_bf16(float lo, float hi) { unsigned r; asm volatile("v_cvt_pk_bf16_f32 %0, %1, %2" : "=v"(r) : "v"(lo), "v"(hi)); return r; }
typedef float f32x2 __attribute__((ext_vector_type(2)));
struct EpiStore {
    static constexpr bool PERM = true, AFTER_DRAIN = false;
    bf16_t* O; int ldc; int act;
    __device__ __forceinline__ void operator()(const f32x4 (&acc)[2][2][4][2], const Unit& u, int wr, int wc, int fr, int fq) const {
        const int row0 = u.pm * BM + wr * 64 + fr, col0 = u.pn * BM + wc * 32 + 8 * fq;
#pragma unroll
        for (int ai = 0; ai < 2; ++ai)
#pragma unroll
            for (int m = 0; m < 4; ++m) { bf16_t* rowp = O + (size_t)(row0 + ai * HALF + m * 16) * ldc + col0;
#pragma unroll
                for (int bj = 0; bj < 2; ++bj) { f32x4 v0 = acc[ai][bj][m][0], v1 = acc[ai][bj][m][1];
                    if (act) { v0 = __builtin_elementwise_max(v0, (f32x4){0.f, 0.f, 0.f, 0.f}); v1 = __builtin_elementwise_max(v1, (f32x4){0.f, 0.f, 0.f, 0.f}); v0 = v0 * v0; v1 = v1 * v1; }
                    u32x4 w; w.x = cvt_pk_bf16(v0[0], v0[1]); w.y = cvt_pk_bf16(v0[2], v0[3]); w.z = cvt_pk_bf16(v1[0], v1[1]); w.w = cvt_pk_bf16(v1[2], v1[3]);
                    *(u32x4*)(rowp + bj * HALF) = w; } }
    }
};
struct EpiResid {
    static constexpr bool PERM = false, AFTER_DRAIN = false;
    const float* xin; float* xout; const float* gate; int gstride;
    __device__ __forceinline__ void operator()(const f32x4 (&acc)[2][2][4][2], const Unit& u, int wr, int wc, int fr, int fq) const {
        const float* gp = gate + (size_t)(u.pm >> 3) * gstride;
        const int col0 = u.pn * BM + wc * 32 + 4 * fq;
        f32x4 gv[2][2];
#pragma unroll
        for (int bj = 0; bj < 2; ++bj)
#pragma unroll
            for (int n = 0; n < 2; ++n) gv[bj][n] = *(const f32x4*)(gp + col0 + bj * HALF + n * 16);
#pragma unroll
        for (int ai = 0; ai < 2; ++ai)
#pragma unroll
            for (int m = 0; m < 4; ++m) { const size_t off = (size_t)(u.pm * BM + ai * HALF + wr * 64 + m * 16 + fr) * 2048 + col0;
#pragma unroll
                for (int bj = 0; bj < 2; ++bj)
#pragma unroll
                    for (int n = 0; n < 2; ++n) { const f32x4 xo = *(const f32x4*)(xin + off + bj * HALF + n * 16); *(f32x4*)(xout + off + bj * HALF + n * 16) = xo + gv[bj][n] * acc[ai][bj][m][n]; }
                asm volatile("" ::: "memory"); }
    }
};
template <class Epi, class Sched, bool ALIGN_EPI = false, bool SP2 = false>
__device__ __forceinline__ void gemm_phase(PG8_LAS unsigned char* lds, const Gemm g, const Sched& S, const Epi& E) {
    const int tid = opaque_tid(), wid = __builtin_amdgcn_readfirstlane(tid >> 6), lane = tid & 63, wr = wid >> 2, wc = wid & 3, fr = lane & 15, fq = lane >> 4;
    const int K = g.K, nt = K / BK;
    unsigned voffA[2], voffB[2];
#pragma unroll
    for (int i = 0; i < 2; ++i) { int R, C; stage_rc(tid * 16 + i * 8192, R, C); const int Rb = Epi::PERM ? ((R & ~31) + perm32(R & 31)) : R;
        voffA[i] = (unsigned)(R * K + C) * 2u; voffB[i] = (unsigned)(Rb * K + C) * 2u; }
    const size_t kstep = (size_t)(BK * 2);
    const size_t hstep = (size_t)HALF * K * 2;
    const size_t tstep = 2 * hstep;
    const unsigned ldsw = (unsigned)wid * 1024u;
    const int aoff = lds_byte(wr * 64 + fr, fq * 8), boff = lds_byte(wc * 32 + fr, fq * 8);
#define PG8_SA(b, h) (((b) * 2 + (h)) * HTB)
#define PG8_SB(b, h) ((4 + (b) * 2 + (h)) * HTB)
#define PG8_STAGE(bufoff, gbase, voff) do { _Pragma("unroll") for (int _i = 0; _i < 2; ++_i) \
        __builtin_amdgcn_global_load_lds((const unsigned*)((const char*)(gbase) + (voff)[_i]), (PG8_LAS unsigned*)(lds + (bufoff) + ldsw + _i * 8192), 16, 0, 0); } while (0)
#define PG8_LDA(dst, b, h) do { _Pragma("unroll") for (int m = 0; m < 4; ++m) _Pragma("unroll") for (int k = 0; k < 2; ++k) dst[m][k] = *(const PG8_LAS bf16x8*)(lds + PG8_SA(b, h) + aoff + m * 2048 + k * 1024); } while (0)
#define PG8_LDB(dst, b, h) do { _Pragma("unroll") for (int n = 0; n < 2; ++n) _Pragma("unroll") for (int k = 0; k < 2; ++k) dst[n][k] = *(const PG8_LAS bf16x8*)(lds + PG8_SB(b, h) + boff + n * 2048 + k * 1024); } while (0)
#define PG8_MMA(ai, bj, At, Bt) do { __builtin_amdgcn_s_setprio(1); _Pragma("unroll") for (int m = 0; m < 4; ++m) _Pragma("unroll") for (int n = 0; n < 2; ++n) _Pragma("unroll") for (int k = 0; k < 2; ++k) \
        acc[ai][bj][m][n] = __builtin_amdgcn_mfma_f32_16x16x32_bf16(Bt[n][k], At[m][k], acc[ai][bj][m][n], 0, 0, 0); __builtin_amdgcn_s_setprio(0); } while (0)
#define PG8_WAIT_V(n) asm volatile("s_waitcnt vmcnt(" #n ")" ::: "memory")
#define PG8_WAIT_L(n) asm volatile("s_waitcnt lgkmcnt(" #n ")" ::: "memory")
#define PG8_BAR __builtin_amdgcn_s_barrier()
#define PG8_SCHED __builtin_amdgcn_sched_barrier(0)
    Unit cur, nxt; int ui = 0;
    if (!S.next(0, cur)) return;
    f32x4 acc[2][2][4][2];
#pragma unroll
    for (int a = 0; a < 2; ++a)
#pragma unroll
        for (int b = 0; b < 2; ++b)
#pragma unroll
            for (int m = 0; m < 4; ++m)
#pragma unroll
                for (int n = 0; n < 2; ++n) acc[a][b][m][n] = (f32x4){0.f, 0.f, 0.f, 0.f};
    bf16x8 At[4][2], B0[2][2], B1[2][2];
    const char* cA = (const char*)g.A + (size_t)cur.pm * tstep; const char* cB = (const char*)g.Bt + (size_t)cur.pn * tstep;
    S.a_ready(cur);
    if constexpr (SP2) {
        PG8_STAGE(PG8_SB(0, 0), cB, voffB); PG8_STAGE(PG8_SB(0, 1), cB + hstep, voffB); PG8_STAGE(PG8_SA(0, 0), cA, voffA); PG8_STAGE(PG8_SA(0, 1), cA + hstep, voffA);
        if (wr == 1) PG8_BAR;
        PG8_WAIT_V(2); PG8_BAR;
        PG8_STAGE(PG8_SB(1, 0), cB + kstep, voffB); PG8_STAGE(PG8_SA(1, 0), cA + kstep, voffA); PG8_STAGE(PG8_SB(1, 1), cB + hstep + kstep, voffB);
        PG8_WAIT_V(6); PG8_BAR;
    } else {
        PG8_STAGE(PG8_SB(0, 0), cB, voffB); PG8_STAGE(PG8_SA(0, 0), cA, voffA); PG8_STAGE(PG8_SB(0, 1), cB + hstep, voffB); PG8_STAGE(PG8_SA(0, 1), cA + hstep, voffA);
        if (wr == 1) PG8_BAR;
        PG8_WAIT_V(4); PG8_BAR;
        PG8_STAGE(PG8_SB(1, 0), cB + kstep, voffB); PG8_STAGE(PG8_SA(1, 0), cA + kstep, voffA); PG8_STAGE(PG8_SB(1, 1), cB + hstep + kstep, voffB);
        PG8_WAIT_V(6); PG8_BAR;
    }
    for (;;) {
        const bool has_next = S.next(ui + 1, nxt);
        const char* nA = has_next ? (const char*)g.A + (size_t)nxt.pm * tstep : cA; const char* nB = has_next ? (const char*)g.Bt + (size_t)nxt.pn * tstep : cB;
        for (int t = 0; t < nt; t += 2) {
            const bool last = (t == nt - 2);
            const char* a1 = cA + (size_t)(t + 1) * kstep;
            const char* a2 = last ? nA : cA + (size_t)(t + 2) * kstep; const char* b2 = last ? nB : cB + (size_t)(t + 2) * kstep;
            const char* a3 = a2 + kstep; const char* b3 = b2 + kstep;
            if (last && has_next) S.a_ready(nxt);
            if constexpr (SP2) {
            PG8_LDB(B0, 0, 0); PG8_LDB(B1, 0, 1); PG8_SCHED; PG8_LDA(At, 0, 0); PG8_STAGE(PG8_SA(1, 1), a1 + hstep, voffA);
            PG8_WAIT_V(8); PG8_WAIT_L(0); PG8_BAR; PG8_MMA(0, 0, At, B0); PG8_MMA(0, 1, At, B1); PG8_BAR; PG8_SCHED;
            PG8_LDA(At, 0, 1); PG8_STAGE(PG8_SB(0, 0), b2, voffB); PG8_STAGE(PG8_SB(0, 1), b2 + hstep, voffB); PG8_STAGE(PG8_SA(0, 0), a2, voffA);
            PG8_WAIT_V(8); PG8_WAIT_L(0); PG8_BAR; PG8_MMA(1, 0, At, B0); PG8_MMA(1, 1, At, B1); PG8_BAR; PG8_SCHED;
            PG8_LDB(B0, 1, 0); PG8_LDB(B1, 1, 1); PG8_SCHED; PG8_LDA(At, 1, 0); PG8_STAGE(PG8_SA(0, 1), a2 + hstep, voffA);
            PG8_WAIT_V(8); PG8_WAIT_L(0); PG8_BAR; PG8_MMA(0, 0, At, B0); PG8_MMA(0, 1, At, B1); PG8_BAR; PG8_SCHED;
            PG8_LDA(At, 1, 1); PG8_STAGE(PG8_SB(1, 0), b3, voffB); PG8_STAGE(PG8_SB(1, 1), b3 + hstep, voffB); PG8_STAGE(PG8_SA(1, 0), a3, voffA);
            PG8_WAIT_V(8); PG8_WAIT_L(0); PG8_BAR; PG8_MMA(1, 0, At, B0); PG8_MMA(1, 1, At, B1); PG8_BAR; PG8_SCHED;
            } else {
            PG8_LDB(B0, 0, 0); PG8_SCHED; PG8_LDA(At, 0, 0); PG8_STAGE(PG8_SA(1, 1), a1 + hstep, voffA);
            PG8_WAIT_L(8); PG8_BAR; PG8_WAIT_L(0); PG8_MMA(0, 0, At, B0); PG8_BAR; PG8_SCHED;
            PG8_LDB(B1, 0, 1); PG8_STAGE(PG8_SB(0, 0), b2, voffB);
            PG8_BAR; PG8_WAIT_L(0); PG8_MMA(0, 1, At, B1); PG8_BAR;
            PG8_LDA(At, 0, 1); PG8_STAGE(PG8_SA(0, 0), a2, voffA);
            PG8_BAR; PG8_WAIT_L(0); PG8_MMA(1, 0, At, B0); PG8_BAR; PG8_SCHED;
            PG8_STAGE(PG8_SB(0, 1), b2 + hstep, voffB);
            PG8_WAIT_V(6); PG8_BAR; PG8_MMA(1, 1, At, B1); PG8_BAR;
            PG8_LDB(B0, 1, 0); PG8_SCHED; PG8_LDA(At, 1, 0); PG8_STAGE(PG8_SA(0, 1), a2 + hstep, voffA);
            PG8_WAIT_L(8); PG8_BAR; PG8_WAIT_L(0); PG8_MMA(0, 0, At, B0); PG8_BAR; PG8_SCHED;
            PG8_LDB(B1, 1, 1); PG8_STAGE(PG8_SB(1, 0), b3, voffB);
            PG8_BAR; PG8_WAIT_L(0); PG8_MMA(0, 1, At, B1); PG8_BAR;
            PG8_LDA(At, 1, 1); PG8_STAGE(PG8_SA(1, 0), a3, voffA);
            PG8_BAR; PG8_WAIT_L(0); PG8_MMA(1, 0, At, B0); PG8_BAR; PG8_SCHED;
            PG8_STAGE(PG8_SB(1, 1), b3 + hstep, voffB);
            PG8_WAIT_V(6); PG8_BAR; PG8_MMA(1, 1, At, B1); PG8_BAR;
            }
        }
        if constexpr (ALIGN_EPI) { if (wr == 0) PG8_BAR; }
        if constexpr (!Epi::AFTER_DRAIN) { E(acc, cur, wr, wc, fr, fq); S.done(cur); }
        if (!has_next) break;
#pragma unroll
        for (int a = 0; a < 2; ++a)
#pragma unroll
            for (int b = 0; b < 2; ++b)
#pragma unroll
                for (int m = 0; m < 4; ++m)
#pragma unroll
                    for (int n = 0; n < 2; ++n) acc[a][b][m][n] = (f32x4){0.f, 0.f, 0.f, 0.f};
        cur = nxt; cA = nA; cB = nB; ++ui;
        if constexpr (ALIGN_EPI) { if (wr == 1) PG8_BAR; }
    }
    PG8_WAIT_V(0);
    if constexpr (!ALIGN_EPI) { if (wr == 0) PG8_BAR; }
    PG8_BAR;
    if constexpr (Epi::AFTER_DRAIN) { E.fused(acc, cur, wr, wc, fr, fq, lds, wid, lane); S.done(cur); }
#undef PG8_SA
#undef PG8_SB
#undef PG8_STAGE
#undef PG8_LDA
#undef PG8_LDB
#undef PG8_MMA
#undef PG8_WAIT_V
#undef PG8_WAIT_L
#undef PG8_BAR
#undef PG8_SCHED
}
}

namespace fa {
constexpr int D = 128;
constexpr float THR = 8.f;
constexpr float SCALE = 0.08838834764831845f;
constexpr int NW = 8, QBLK = 32, KVBLK = 64, QB = NW * QBLK;
constexpr int SHM_V = KVBLK * D * 2, SHM_K = KVBLK * D * 2;
constexpr int LDS_BYTES = 2 * SHM_V + 2 * SHM_K + NW * 64 * 4;

typedef unsigned short bf16;
typedef short bf16x8 __attribute__((ext_vector_type(8)));
typedef short s16x4 __attribute__((ext_vector_type(4)));
typedef float f32x16 __attribute__((ext_vector_type(16)));
typedef float f32x4 __attribute__((ext_vector_type(4)));
typedef unsigned u32x4 __attribute__((ext_vector_type(4)));
template <class A, class Bt> struct same_t { static constexpr bool v = false; };
template <class A> struct same_t<A, A> { static constexpr bool v = true; };

#define KSWZ(row, colB) ((row) * 256 + ((colB) ^ (((row) & 7) << 4)))
#define SBAR() __builtin_amdgcn_sched_barrier(0)
__device__ __forceinline__ int v_st(int k, int c) { const int kk = (k & ~0xC) | ((k & 4) << 1) | ((k & 8) >> 1); return ((kk >> 3) * 4 + (c >> 5)) * 512 + ((kk & 7) * 32 + (c & 31)) * 2; }
__device__ __forceinline__ int v_rd_base(int lane) { return ((lane & 3) << 3) | (((lane >> 2) & 3) << 6) | (((lane >> 4) & 1) << 5) | (((lane >> 5) & 1) << 8); }
constexpr int v_rd_off(int d0, int ks, int half) { return d0 * 512 + ks * 4096 + half * 2048; }
__device__ __forceinline__ int crow(int r, int hi) { return (r & 3) + 8 * (r >> 2) + 4 * hi; }
__device__ __forceinline__ unsigned cvtpk(float lo, float hi) {
    unsigned r; asm volatile("v_cvt_pk_bf16_f32 %0, %1, %2" : "=v"(r) : "v"(lo), "v"(hi)); return r;
}
__device__ __forceinline__ bf16x8 pack8(f32x4 a, f32x4 b) {
    u32x4 w = {cvtpk(a[0], a[1]), cvtpk(a[2], a[3]), cvtpk(b[0], b[1]), cvtpk(b[2], b[3])};
    return *reinterpret_cast<bf16x8*>(&w);
}
template <class T> __device__ __forceinline__ bf16x8 load8(const T* p) {
    if constexpr (same_t<T, float>::v) { return pack8(*(const f32x4*)p, *(const f32x4*)(p + 4)); }
    else { return *reinterpret_cast<const bf16x8*>(p); }
}
__device__ __forceinline__ void mask_tile(f32x16& p0, f32x16& p1, int dq, unsigned W) {
    const float NEG = -__builtin_inff();
#pragma unroll
    for (int r = 0; r < 16; ++r) {
        const int c = (r & 3) + 8 * (r >> 2);
        if ((unsigned)(dq - c) >= W) p0[r] = NEG;
        if ((unsigned)(dq - c - 32) >= W) p1[r] = NEG;
    }
}
__device__ __forceinline__ void sel_tile(f32x16& p0, f32x16& p1, bool keep) {
    const float NEG = -__builtin_inff();
#pragma unroll
    for (int r = 0; r < 16; ++r) { p0[r] = keep ? p0[r] : NEG; p1[r] = keep ? p1[r] : NEG; }
}
__device__ __forceinline__ void partialSM(f32x16& p0, f32x16& p1, float& m_reg, float& mn, float& alpha) {
    float pmax = p0[0]; for (int r = 1; r < 16; ++r) pmax = fmaxf(pmax, p0[r]); for (int r = 0; r < 16; ++r) pmax = fmaxf(pmax, p1[r]);
    { auto rr = __builtin_amdgcn_permlane32_swap(__float_as_uint(pmax), __float_as_uint(pmax), false, false);
      pmax = fmaxf(__uint_as_float(rr[0]), __uint_as_float(rr[1])); }
    constexpr float C2 = 1.4426950408889634f * SCALE;
    if (__builtin_expect(__all((pmax - m_reg) * SCALE <= THR), 1)) { mn = m_reg; alpha = 1.f; }
    else { mn = fmaxf(m_reg, pmax); alpha = __builtin_amdgcn_exp2f((m_reg - mn) * C2); m_reg = mn; }
    const float mnL = -mn * C2;
    for (int r = 0; r < 16; ++r) p0[r] = fmaf(p0[r], C2, mnL); for (int r = 0; r < 16; ++r) p1[r] = fmaf(p1[r], C2, mnL);
    for (int r = 0; r < 16; ++r) p0[r] = __builtin_amdgcn_exp2f(p0[r]);
}
__device__ __forceinline__ void finishSM(f32x16& p0, f32x16& p1, float alpha, float& l_reg, bf16x8& pa0, bf16x8& pa1, bf16x8& pa2, bf16x8& pa3) {
    for (int r = 0; r < 16; ++r) p1[r] = __builtin_amdgcn_exp2f(p1[r]);
    float ps = 0; for (int r = 0; r < 16; ++r) ps += p0[r]; for (int r = 0; r < 16; ++r) ps += p1[r];
    { auto rr = __builtin_amdgcn_permlane32_swap(__float_as_uint(ps), __float_as_uint(ps), false, false);
      ps = __uint_as_float(rr[0]) + __uint_as_float(rr[1]); }
    l_reg = l_reg * alpha + ps;
#define PK4(P, B_, OUT) do { unsigned a0 = cvtpk(P[B_+0], P[B_+1]), a1 = cvtpk(P[B_+2], P[B_+3]);                          \
        unsigned b0 = cvtpk(P[B_+4], P[B_+5]), b1 = cvtpk(P[B_+6], P[B_+7]);                                             \
        auto r0 = __builtin_amdgcn_permlane32_swap(a0, b0, false, false); auto r1 = __builtin_amdgcn_permlane32_swap(a1, b1, false, false); \
        u32x4 w = {r0[0], r1[0], r0[1], r1[1]}; OUT = *reinterpret_cast<bf16x8*>(&w); } while (0)
    PK4(p0, 0, pa0); PK4(p0, 8, pa1); PK4(p1, 0, pa2); PK4(p1, 8, pa3);
#undef PK4
}
template <int KB, bool SK>
__device__ __forceinline__ void qkt(f32x16& p0, f32x16& p1, const char* K_lds, int r32, int hi, const bf16x8* qr, bool act) {
    if (SK && !act) { const float NEG = -__builtin_inff();
#pragma unroll
        for (int r = 0; r < 16; ++r) { p0[r] = NEG; p1[r] = NEG; } return; }
    p0 = f32x16{}; p1 = f32x16{};
    const char* kb[4];
#pragma unroll
    for (int dd = 0; dd < 4; ++dd) kb[dd] = K_lds + KB * SHM_K + KSWZ(r32, (dd * 16 + hi * 8) * 2);
#pragma unroll
    for (int d0 = 0; d0 < 8; ++d0) { const char* a = kb[d0 & 3] + (d0 >> 2) * 128;
        bf16x8 b0 = *reinterpret_cast<const bf16x8*>(a);
        bf16x8 b1 = *reinterpret_cast<const bf16x8*>(a + 32 * 256);
        p0 = __builtin_amdgcn_mfma_f32_32x32x16_bf16(b0, qr[d0], p0, 0, 0, 0);
        p1 = __builtin_amdgcn_mfma_f32_32x32x16_bf16(b1, qr[d0], p1, 0, 0, 0); }
}
template <int VB, bool SK>
__device__ __forceinline__ void pv_tile(f32x16* o, int vb0, bf16x8 pa0, bf16x8 pa1, bf16x8 pa2, bf16x8 pa3, bool act) {
    if (SK && !act) return;
#define TRRD(dst, off) asm volatile("ds_read_b64_tr_b16 %0, %1 offset:%2" : "=&v"(dst) : "v"(vb0), "i"(off) : "memory")
#define PV_D0(d0) do { s16x4 l0, l1, l2, l3, h0, h1, h2, h3; constexpr int b_ = VB * SHM_V + v_rd_off(d0, 0, 0);     \
        TRRD(l0, b_); TRRD(h0, b_ + 2048); TRRD(l1, b_ + 4096); TRRD(h1, b_ + 6144); TRRD(l2, b_ + 8192); TRRD(h2, b_ + 10240); TRRD(l3, b_ + 12288); TRRD(h3, b_ + 14336); \
        asm volatile("s_waitcnt lgkmcnt(0)" ::: "memory"); SBAR();                 \
        o[d0] = __builtin_amdgcn_mfma_f32_32x32x16_bf16(pa0, (bf16x8){l0[0], l0[1], l0[2], l0[3], h0[0], h0[1], h0[2], h0[3]}, o[d0], 0, 0, 0);   \
        o[d0] = __builtin_amdgcn_mfma_f32_32x32x16_bf16(pa1, (bf16x8){l1[0], l1[1], l1[2], l1[3], h1[0], h1[1], h1[2], h1[3]}, o[d0], 0, 0, 0);   \
        o[d0] = __builtin_amdgcn_mfma_f32_32x32x16_bf16(pa2, (bf16x8){l2[0], l2[1], l2[2], l2[3], h2[0], h2[1], h2[2], h2[3]}, o[d0], 0, 0, 0);   \
        o[d0] = __builtin_amdgcn_mfma_f32_32x32x16_bf16(pa3, (bf16x8){l3[0], l3[1], l3[2], l3[3], h3[0], h3[1], h3[2], h3[3]}, o[d0], 0, 0, 0); } while (0)
    PV_D0(0); PV_D0(1); PV_D0(2); PV_D0(3);
#undef PV_D0
#undef TRRD
}

template <class TIn, class TOut> struct BlockRef { const TIn* Q; const TIn* K; const TIn* V; TOut* O; const unsigned* sel; int P0; int W; int os; };
template <class TIn> struct Seam {
    bf16x8 qr[8];
    bf16x8 st_v0, st_v1, st_k0, st_k1; f32x4 sf0, sf1, sf2, sf3;
    f32x4 tq[16];
};
__device__ __forceinline__ int swa_jlo(int P0, int W) { const int lowk = P0 - W + 1; return lowk > 0 ? lowk / KVBLK : 0; }
#define ROW(p, k0, rr) ((p) + (size_t)((k0) + (rr)) * D + sc)
#define VMW() asm volatile("s_waitcnt vmcnt(0)" ::: "memory")
#define VMWN(n) asm volatile("s_waitcnt vmcnt(%0)" :: "i"(n) : "memory")
#define SLOAD_H(Kp, Vp, k0) do { S.st_v0 = load8<TIn>(ROW(Vp, k0, sr)); S.st_v1 = load8<TIn>(ROW(Vp, k0, 32 + sr));              \
                         S.st_k0 = load8<TIn>(ROW(Kp, k0, sr)); S.st_k1 = load8<TIn>(ROW(Kp, k0, 32 + sr)); } while (0)
#define SWRITE_HK(bf) do { *(bf16x8*)(K_lds + (bf) * SHM_K + kws) = S.st_k0; *(bf16x8*)(K_lds + (bf) * SHM_K + kws + 32 * 256) = S.st_k1; } while (0)
#define SWRITE_HV(bf) do { *(bf16x8*)(V_lds + (bf) * SHM_V + vst0) = S.st_v0; *(bf16x8*)(V_lds + (bf) * SHM_V + vst1) = S.st_v1; } while (0)
#define SWRITE_H(bf) do { SWRITE_HV(bf); SWRITE_HK(bf); } while (0)
#define SLOAD_F(p, k0) do { S.sf0 = *(const f32x4*)ROW(p, k0, sr); S.sf1 = *(const f32x4*)(ROW(p, k0, sr) + 4);                \
                            S.sf2 = *(const f32x4*)ROW(p, k0, 32 + sr); S.sf3 = *(const f32x4*)(ROW(p, k0, 32 + sr) + 4); } while (0)
#define SWRITE_KF(bf) do { *(bf16x8*)(K_lds + (bf) * SHM_K + kws) = pack8(S.sf0, S.sf1); *(bf16x8*)(K_lds + (bf) * SHM_K + kws + 32 * 256) = pack8(S.sf2, S.sf3); } while (0)
#define SWRITE_VF(bf) do { *(bf16x8*)(V_lds + (bf) * SHM_V + vst0) = pack8(S.sf0, S.sf1); *(bf16x8*)(V_lds + (bf) * SHM_V + vst1) = pack8(S.sf2, S.sf3); } while (0)
template <class TIn, class TOut>
__device__ __forceinline__ void causal_swa_prime(const BlockRef<TIn, TOut>& cur, char* lds, Seam<TIn>& S) {
    const int W = cur.W;
    constexpr bool F32 = same_t<TIn, float>::v;
    const int tid = opaque_tid(), wid = __builtin_amdgcn_readfirstlane(tid >> 6), lane = tid & 63, r32 = lane & 31, hi = lane >> 5;
    const int sr = tid >> 4, sc = (tid & 15) * 8, kws = KSWZ(sr, sc * 2); char* K_lds = lds + 2 * SHM_V;
    const int kb0 = swa_jlo(cur.P0, W) * KVBLK;
    for (int d0 = 0; d0 < 8; ++d0) S.qr[d0] = load8<TIn>(cur.Q + (size_t)(wid * QBLK + r32) * D + d0 * 16 + hi * 8);
    if constexpr (F32) { SLOAD_F((const float*)cur.K, kb0); VMW(); SWRITE_KF(0); SBAR(); SLOAD_F((const float*)cur.V, kb0); }
    else { SLOAD_H(cur.K, cur.V, kb0); VMW(); SWRITE_HK(0); }
    __syncthreads();
}
template <class TOut> struct OutRef { TOut* O; int os; };
template <class TIn, class TOut, class NX, class OX>
__device__ __forceinline__ void causal_swa_block(const BlockRef<TIn, TOut>& cur, const NX& nxf, const OX& oxf, int skv, char* lds, Seam<TIn>& S) {
    const int W = cur.W;
    constexpr bool F32 = same_t<TIn, float>::v;
    const int tid = opaque_tid(), wid = __builtin_amdgcn_readfirstlane(tid >> 6), lane = tid & 63, r32 = lane & 31, hi = lane >> 5;
    const int j_lo = swa_jlo(cur.P0, W);
    int j_hi = (cur.P0 + QB - 1) / KVBLK + 1; if (j_hi > skv / KVBLK) j_hi = skv / KVBLK;
    const int NT = j_hi - j_lo;
    const int qlo = cur.P0 + wid * QBLK, qm = qlo + r32 - 4 * hi;
    char* V_lds = lds; char* K_lds = lds + 2 * SHM_V;
    float* ws = (float*)(lds + 2 * SHM_V + 2 * SHM_K) + wid * 64; float* li_l = ws, * al_l = ws + 32;
    float m_reg = -1e30f, l_reg = 0; f32x16 o[4] = {};
    const bool has_sel = cur.sel != nullptr;
    const unsigned selw = has_sel ? cur.sel[qlo + r32] : 0xffffffffu;
    const int sr = tid >> 4, sc = (tid & 15) * 8, vst0 = v_st(sr, sc), vst1 = v_st(32 + sr, sc), kws = KSWZ(sr, sc * 2);
    const int vb0 = (int)(uintptr_t)V_lds + v_rd_base(lane);
    const TIn* Kh = cur.K; const TIn* Vh = cur.V;
#define RESC(a) do { if (__any((a) < 1.f)) { if (hi == 0) al_l[r32] = (a); asm volatile("s_waitcnt lgkmcnt(0)" ::: "memory");              \
                     for (int d_ = 0; d_ < 4; ++d_) for (int r = 0; r < 16; ++r) o[d_][r] *= al_l[crow(r, hi)]; } } while (0)
#define KBASE(t) ((j_lo + (t)) * KVBLK)
#define ACT(t) (KBASE(t) <= qlo + QBLK - 1 && KBASE(t) + KVBLK - 1 >= qlo - W + 1)
#define MASKT(P0_, P1_, t) do { const int kb_ = KBASE(t); if ((!SK || ACT(t)) && (kb_ + KVBLK - 1 > qlo || kb_ <= qlo + QBLK - 1 - W)) mask_tile(P0_, P1_, qm - kb_, (unsigned)W); \
        if (has_sel) sel_tile(P0_, P1_, ((selw >> (j_lo + (t))) & 1u) != 0u); } while (0)
    constexpr int NQL = F32 ? 16 : 8;
    constexpr bool SK = false;
#define SEAM_K0() do { VMWN(NQL); if constexpr (F32) { SWRITE_KF(0); SBAR(); SLOAD_F((const float*)nxt.V, kbn); } else { SWRITE_HK(0); } SBAR(); } while (0)
    f32x16 pA0, pA1, pB0, pB1; float mnA, mnB, alA, alB; bf16x8 pa0, pa1, pa2, pa3;
    if constexpr (F32) { VMW(); SWRITE_VF(0); SBAR(); } else { SWRITE_HV(0); SBAR(); }
    if (NT > 1) { if constexpr (F32) SLOAD_F((const float*)Kh, KBASE(1)); else SLOAD_H(Kh, Vh, KBASE(1)); }
    SBAR(); qkt<0, SK>(pA0, pA1, K_lds, r32, hi, S.qr, ACT(0));
    if constexpr (F32) { if (NT > 1) { VMW(); SWRITE_KF(1); SBAR(); SLOAD_F((const float*)Vh, KBASE(1)); } }
    MASKT(pA0, pA1, 0); partialSM(pA0, pA1, m_reg, mnA, alA);
    if (NT > 1) { VMW(); if constexpr (F32) { SWRITE_VF(1); SBAR(); if (NT > 2) SLOAD_F((const float*)Kh, KBASE(2)); } else SWRITE_H(1); }
    __syncthreads();
#define HALF_STEP(PX0, PX1, mnX, alX, PY0, PY1, alY, t, KB, VB, SB) do {                                                      \
        SBAR(); qkt<KB, SK>(PX0, PX1, K_lds, r32, hi, S.qr, ACT(t));                                             \
        finishSM(PY0, PY1, alY, l_reg, pa0, pa1, pa2, pa3); SBAR();                                                           \
        if ((t) + 1 < NT) { if constexpr (F32) { VMW(); SWRITE_KF(SB); SBAR(); SLOAD_F((const float*)Vh, KBASE((t) + 1)); }  \
                            else { SLOAD_H(Kh, Vh, KBASE((t) + 1)); } SBAR(); }                                               \
        pv_tile<VB, SK>(o, vb0, pa0, pa1, pa2, pa3, ACT((t) - 1)); MASKT(PX0, PX1, (t)); partialSM(PX0, PX1, m_reg, mnX, alX);                                        \
        __syncthreads();                                                                                                      \
        if ((t) + 1 < NT) { VMW(); if constexpr (F32) { SWRITE_VF(SB); SBAR(); if ((t) + 2 < NT) SLOAD_F((const float*)Kh, KBASE((t) + 2)); } \
                            else { SWRITE_H(SB); } }                                                                          \
        RESC(alX); __syncthreads(); } while (0)
    for (int t = 1; t + 1 < NT; t += 2) {
        HALF_STEP(pB0, pB1, mnB, alB, pA0, pA1, alA, t, 1, 0, 0);
        HALF_STEP(pA0, pA1, mnA, alA, pB0, pB1, alB, t + 1, 0, 1, 1);
    }
    const bool even = (NT & 1) == 0;
    if (even) { SBAR(); qkt<1, SK>(pB0, pB1, K_lds, r32, hi, S.qr, ACT(NT - 1)); SBAR(); }
    const BlockRef<TIn, TOut> nxt = nxf(); const int kbn = swa_jlo(nxt.P0, nxt.W) * KVBLK;
#define QROW(e) (nxt.Q + (size_t)(wid * QBLK + r32) * D + ((e) >> 1) * 16 + hi * 8 + ((e) & 1) * 4)
    if constexpr (F32) { SLOAD_F((const float*)nxt.K, kbn); SBAR();
#pragma unroll
        for (int e = 0; e < 8; ++e) S.tq[e] = *(const f32x4*)QROW(e); }
    else { SLOAD_H(nxt.K, nxt.V, kbn); SBAR();
#pragma unroll
        for (int d0 = 0; d0 < 8; ++d0) S.qr[d0] = load8<TIn>(nxt.Q + (size_t)(wid * QBLK + r32) * D + d0 * 16 + hi * 8); }
    SBAR();
    finishSM(pA0, pA1, alA, l_reg, pa0, pa1, pa2, pa3); SBAR();
    if constexpr (F32) {
#pragma unroll
        for (int e = 8; e < 16; ++e) S.tq[e] = *(const f32x4*)QROW(e); SBAR(); }
#undef QROW
    pv_tile<0, SK>(o, vb0, pa0, pa1, pa2, pa3, ACT(even ? NT - 2 : NT - 1));
    if (even) { MASKT(pB0, pB1, NT - 1); partialSM(pB0, pB1, m_reg, mnB, alB); __syncthreads(); RESC(alB);
        finishSM(pB0, pB1, alB, l_reg, pa0, pa1, pa2, pa3); SBAR(); pv_tile<1, SK>(o, vb0, pa0, pa1, pa2, pa3, ACT(NT - 1)); }
    SBAR(); SEAM_K0();
    if (hi == 0) li_l[r32] = l_reg; asm volatile("s_waitcnt lgkmcnt(0)" ::: "memory");
    float rli[16];
#pragma unroll
    for (int r = 0; r < 16; ++r) rli[r] = __builtin_amdgcn_rcpf(li_l[crow(r, hi)]);
    const OutRef<TOut> orf = oxf(); const int os = orf.os; TOut* Ow = orf.O + (size_t)(wid * QBLK) * os;
#pragma unroll
    for (int r = 0; r < 16; ++r) { const int orow = crow(r, hi);
#pragma unroll
        for (int d0 = 0; d0 < 4; ++d0) { const float v = o[d0][r] * rli[r];
            if constexpr (same_t<TOut, float>::v) { Ow[(size_t)orow * os + d0 * 32 + r32] = v; }
            else { const float vn = __shfl_xor(v, 1);
                   if ((r32 & 1) == 0) *(unsigned*)(Ow + (size_t)orow * os + d0 * 32 + r32) = cvtpk(v, vn); } } }
    if constexpr (F32) {
#pragma unroll
        for (int d0 = 0; d0 < 8; ++d0) S.qr[d0] = pack8(S.tq[2 * d0], S.tq[2 * d0 + 1]); }
    __syncthreads();
#undef RESC
#undef KBASE
#undef ACT
#undef MASKT
#undef SEAM_K0
#undef HALF_STEP
}
#undef ROW
#undef VMW
#undef VMWN
#undef SLOAD_H
#undef SWRITE_HK
#undef SWRITE_HV
#undef SWRITE_H
#undef SLOAD_F
#undef SWRITE_KF
#undef SWRITE_VF

}

#define GAS __attribute__((address_space(1)))
#define LAS __attribute__((address_space(3)))
typedef unsigned short bf16;
typedef unsigned v4u __attribute__((ext_vector_type(4)));
typedef float f32x4 __attribute__((ext_vector_type(4)));
typedef short bf16x8 __attribute__((ext_vector_type(8)));
typedef GAS unsigned gu32;
typedef GAS unsigned long long gu64;
#define RLX_AGENT __ATOMIC_RELAXED, __HIP_MEMORY_SCOPE_AGENT
#define LDS_WAIT() asm volatile("s_waitcnt lgkmcnt(0)" ::: "memory")
#define VM_WAIT() asm volatile("s_waitcnt vmcnt(0)" ::: "memory")
__device__ __forceinline__ unsigned long long rt() { return __builtin_amdgcn_s_memrealtime(); }
__device__ __forceinline__ unsigned f2bf(float f) { unsigned u = __builtin_bit_cast(unsigned, f); return (u + 0x7fffu + ((u >> 16) & 1u)) >> 16; }
__device__ __forceinline__ unsigned pk2(float lo, float hi) { return f2bf(lo) | (f2bf(hi) << 16); }

#define XB_TMO      128
#define XB_XCNT(j)  (256  + 64 * (j))
#define XB_XSUB(j)  (1280 + 64 * (j))
#define XB_XGEN(j)  (2304 + 64 * (j))
#define XB_TOP      3328
#define XB_TOPGEN   3392
#define XCD_BAR_WORDS 3456
#define XB_SPIN_CAP (1u << 18)

__device__ __forceinline__ unsigned xb_ld(unsigned* p)              { return __hip_atomic_load(p, __ATOMIC_RELAXED, __HIP_MEMORY_SCOPE_AGENT); }
__device__ __forceinline__ unsigned xb_add(unsigned* p, unsigned v) { return __hip_atomic_fetch_add(p, v, __ATOMIC_RELAXED, __HIP_MEMORY_SCOPE_AGENT); }
__device__ __forceinline__ unsigned xb_xcc_id() { return (unsigned)__builtin_amdgcn_s_getreg((3 << 11) | 20) & 0xFu; }
#define XB_SPIN(cond, bar) do { unsigned _sp = 0; while (cond) { __builtin_amdgcn_s_sleep(1); \
    if ((++_sp & 255u) == 0u) { if (xb_ld(&(bar)[XB_TMO])) break; if (_sp > XB_SPIN_CAP) { atomicAdd(&(bar)[XB_TMO], 1u); break; } } } } while (0)

struct XcdBarrier {
    unsigned* bar; unsigned x;
    volatile LAS unsigned* st;
};

__device__ __forceinline__ XcdBarrier xcd_barrier_post(unsigned* bar, volatile LAS unsigned* st) {
    XcdBarrier b; b.bar = bar; b.x = xb_xcc_id(); b.st = st;
    if (threadIdx.x == 0) (void)xb_add(&bar[XB_XCNT(b.x)], 1u);
    return b;
}
__device__ __forceinline__ void xcd_barrier_complete(unsigned* bar, unsigned x, unsigned& nloc, unsigned& nx) {
    const unsigned G = gridDim.x * gridDim.y * gridDim.z;
    unsigned sum, cnt, mine, sp = 0u;
    for (;;) {
        sum = 0u; cnt = 0u; mine = 0u;
#pragma unroll
        for (unsigned j = 0; j < 16; ++j) { const unsigned c = xb_ld(&bar[XB_XCNT(j)]); sum += c; cnt += (c > 0u) ? 1u : 0u; mine = (j == x) ? c : mine; }
        if (sum == G) break;
        __builtin_amdgcn_s_sleep(1);
        if ((++sp & 255u) == 0u) { if (xb_ld(&bar[XB_TMO])) break; if (sp > XB_SPIN_CAP) { atomicAdd(&bar[XB_TMO], 1u); break; } }
    }
    nloc = mine > 0u ? mine : 1u; nx = cnt > 0u ? cnt : 1u;
}

__device__ __forceinline__ void xcd_barrier(const XcdBarrier& b) {
    asm volatile("s_waitcnt vmcnt(0)" ::: "memory");
    __syncthreads();
    if (threadIdx.x == 0) {
        unsigned* bar = b.bar;
        __builtin_amdgcn_s_waitcnt(0);
        unsigned nloc = b.st[0], nx = b.st[1];
        if (nloc == 0u) { xcd_barrier_complete(bar, b.x, nloc, nx); b.st[0] = nloc; b.st[1] = nx; }
        const unsigned old = xb_add(&bar[XB_XSUB(b.x)], 1u);
        const unsigned gen = old / nloc;
        if (old + 1u == (gen + 1u) * nloc) {
            __builtin_amdgcn_fence(__ATOMIC_RELEASE, "agent");
            asm volatile("s_waitcnt vmcnt(0)" ::: "memory");
            const unsigned og = xb_add(&bar[XB_TOP], 1u);
            const unsigned tg = og / nx;
            if (og + 1u == (tg + 1u) * nx) xb_add(&bar[XB_TOPGEN], 1u);
            else XB_SPIN(xb_ld(&bar[XB_TOPGEN]) == tg, bar);
            __builtin_amdgcn_fence(__ATOMIC_ACQUIRE, "agent");
            xb_add(&bar[XB_XGEN(b.x)], 1u);
            asm volatile("s_waitcnt vmcnt(0)" ::: "memory");
        } else {
            XB_SPIN(xb_ld(&bar[XB_XGEN(b.x)]) == gen, bar);
            __builtin_amdgcn_fence(__ATOMIC_ACQUIRE, "agent");
            asm volatile("s_waitcnt vmcnt(0)" ::: "memory");
        }
    }
    __syncthreads();
}

#define DEVI __device__ __forceinline__
typedef float f32x16 __attribute__((ext_vector_type(16)));
typedef unsigned u32x2 __attribute__((ext_vector_type(2)));
typedef float f32x2 __attribute__((ext_vector_type(2)));

constexpr int DM = 2048, NB = 8, T = 2048, M = NB * T, DFF = 8192;
constexpr int NSA_IN = 5168, NSA_INP = 5376, DIFF_IN = 6144, MODW = 6 * DM;
constexpr float EPS = 1e-6f;
constexpr int NWAVES = 8;

constexpr size_t MiB = 1u << 20;
constexpr size_t WS_CTL = 0, CTL_ZERO_BYTES = 1 * MiB;
constexpr size_t WS_MODP = 1 * MiB;
constexpr size_t WS_MOD = 13 * MiB;
constexpr size_t WS_ROPE = 15 * MiB;
constexpr size_t WS_GATES = 23 * MiB;
constexpr size_t WS_SEL = 26 * MiB;
constexpr size_t WS_KCMP = 27 * MiB;
constexpr size_t WS_VCMP = 28 * MiB;
constexpr size_t WS_CW2 = 29 * MiB;
constexpr size_t WS_CW1 = 30 * MiB;
constexpr size_t WS_W1T = 38 * MiB;
constexpr size_t WS_W2T = 166 * MiB;
constexpr size_t WS_NWIN = 294 * MiB;
constexpr size_t WS_NWOUT = 336 * MiB;
constexpr size_t WS_DWIN = 352 * MiB;
constexpr size_t WS_DWOUT = 400 * MiB;
constexpr size_t WS_H = 416 * MiB;
constexpr size_t WS_AO = 480 * MiB;
constexpr size_t WS_RAW = 544 * MiB;
constexpr size_t WS_QHM = 736 * MiB;
constexpr size_t WS_HID = 544 * MiB;
constexpr size_t WS_KA = 800 * MiB;
constexpr size_t WS_VA = 864 * MiB;
constexpr size_t WS_O0 = 928 * MiB;
constexpr size_t WS_END = 1120 * MiB;

constexpr int CW_BAR = 4096;

constexpr int LDSCTL_OFF = 143360, PTR_OFF = LDSCTL_OFF + 64, MISC_OFF = LDSCTL_OFF + 320, LDS_BYTES = 147456;

struct Ctx { LAS unsigned char* lds; char* ldsg; int tid, lane, wave, bid, vcu, G, gw, NGW; };
DEVI const float* inp(const Ctx& F, int k) { const LAS unsigned* p = (const LAS unsigned*)(F.lds + PTR_OFF) + 2 * k; const unsigned lo = __builtin_amdgcn_readfirstlane(p[0]), hi = __builtin_amdgcn_readfirstlane(p[1]);
    return (const float*)(((unsigned long long)hi << 32) | lo); }

__device__ const float ROPE_INV[64] = {
1.000000000e+00f, 8.659643531e-01f, 7.498942018e-01f, 6.493816376e-01f, 5.623413324e-01f, 4.869675338e-01f, 4.216965139e-01f, 3.651741147e-01f, 3.162277639e-01f, 2.738419771e-01f, 2.371373773e-01f, 2.053525001e-01f, 1.778279394e-01f, 1.539926529e-01f, 1.333521456e-01f, 1.154781953e-01f,
1.000000015e-01f, 8.659642935e-02f, 7.498942316e-02f, 6.493816525e-02f, 5.623413250e-02f, 4.869675264e-02f, 4.216964915e-02f, 3.651741147e-02f, 3.162277490e-02f, 2.738419548e-02f, 2.371373773e-02f, 2.053525113e-02f, 1.778279431e-02f, 1.539926510e-02f, 1.333521400e-02f, 1.154781971e-02f,
9.999999776e-03f, 8.659643121e-03f, 7.498942316e-03f, 6.493816152e-03f, 5.623413250e-03f, 4.869675264e-03f, 4.216964822e-03f, 3.651741194e-03f, 3.162277630e-03f, 2.738419687e-03f, 2.371373819e-03f, 2.053525066e-03f, 1.778279431e-03f, 1.539926510e-03f, 1.333521446e-03f, 1.154782018e-03f,
1.000000047e-03f, 8.659643354e-04f, 7.498941850e-04f, 6.493816036e-04f, 5.623413017e-04f, 4.869675322e-04f, 4.216965172e-04f, 3.651741135e-04f, 3.162277571e-04f, 2.738419571e-04f, 2.371373703e-04f, 2.053525095e-04f, 1.778279402e-04f, 1.539926598e-04f, 1.333521504e-04f, 1.154782003e-04f};

DEVI float bflo(unsigned w) { return __uint_as_float(w << 16); }
DEVI float bfhi(unsigned w) { return __uint_as_float(w & 0xffff0000u); }
DEVI float wave_sum(float v) {
#pragma unroll
    for (int o = 1; o < 64; o <<= 1) v += __shfl_xor(v, o);
    return v;
}
DEVI f32x16 mfma32(bf16x8 a, bf16x8 b, f32x16 c) { return __builtin_amdgcn_mfma_f32_32x32x16_bf16(a, b, c, 0, 0, 0); }
DEVI int crow(int r, int hi) { return (r & 3) + 8 * (r >> 2) + 4 * hi; }

DEVI void tr_item(const float* W, int K, int N, bf16* WT, LAS float* scr, int kb, int nb, int lane) {
    const int k0 = 64 * kb, n0 = 32 * nb, nn = n0 + (lane & 31); const bool ok = nn < N;
#pragma unroll 8
    for (int i = 0; i < 32; ++i) { const int kk = 2 * i + (lane >> 5); scr[kk * 33 + (lane & 31)] = ok ? W[(size_t)(k0 + kk) * N + nn] : 0.f; }
    LDS_WAIT(); asm volatile("" ::: "memory");
    const int c = lane & 7;
#pragma unroll
    for (int j = 0; j < 4; ++j) { const int n = (lane >> 3) + 8 * j; const LAS float* s = scr + (8 * c) * 33 + n;
        v4u o; o.x = pk2(s[0 * 33], s[1 * 33]); o.y = pk2(s[2 * 33], s[3 * 33]); o.z = pk2(s[4 * 33], s[5 * 33]); o.w = pk2(s[6 * 33], s[7 * 33]);
        *(GAS v4u*)(WT + (size_t)(n0 + n) * K + k0 + 8 * c) = o; }
    LDS_WAIT(); asm volatile("" ::: "memory");
}

DEVI void p0_prologue(const Ctx& F, unsigned char* ws) {
    LAS float* scL = (LAS float*)(F.lds);
    { const float* cc = inp(F, 1);
      for (int idx = F.tid; idx < NB * DM; idx += NWAVES * 64) { const int b = idx >> 11, k = idx & 2047; const float v = cc[idx]; scL[k * 8 + b] = v / (1.f + expf(-v)); } }
    __syncthreads();
    for (int id = F.gw; id < 1536; id += F.NGW) {
        const int l = id / 384, rem = id % 384, ks = rem / 48, cg = rem % 48, col0 = cg * 256 + 4 * F.lane, k0 = ks * 256;
        const float* wp = inp(F, 3) + ((size_t)l * DM + k0) * MODW + col0;
        f32x4 a0 = {0, 0, 0, 0}, a1 = a0, a2 = a0, a3 = a0, a4 = a0, a5 = a0, a6 = a0, a7 = a0;
        for (int kk = 0; kk < 256; kk += 8) {
            f32x4 w[8];
#pragma unroll
            for (int u = 0; u < 8; ++u) w[u] = *(const GAS f32x4*)(wp + (size_t)(kk + u) * MODW);
#pragma unroll
            for (int u = 0; u < 8; ++u) { const f32x4 s0 = *(const LAS f32x4*)(scL + (k0 + kk + u) * 8), s1 = *(const LAS f32x4*)(scL + (k0 + kk + u) * 8 + 4);
                a0 += s0.x * w[u]; a1 += s0.y * w[u]; a2 += s0.z * w[u]; a3 += s0.w * w[u]; a4 += s1.x * w[u]; a5 += s1.y * w[u]; a6 += s1.z * w[u]; a7 += s1.w * w[u]; }
        }
        float* pp = (float*)(ws + WS_MODP) + (((size_t)ks * 4 + l) * 8) * MODW + col0;
        *(GAS f32x4*)(pp + 0 * MODW) = a0; *(GAS f32x4*)(pp + 1 * MODW) = a1; *(GAS f32x4*)(pp + 2 * MODW) = a2; *(GAS f32x4*)(pp + 3 * MODW) = a3;
        *(GAS f32x4*)(pp + 4 * MODW) = a4; *(GAS f32x4*)(pp + 5 * MODW) = a5; *(GAS f32x4*)(pp + 6 * MODW) = a6; *(GAS f32x4*)(pp + 7 * MODW) = a7;
    }
    { const int* pos = (const int*)inp(F, 2); float* rope = (float*)(ws + WS_ROPE); const float inv = ROPE_INV[F.lane];
      for (int m = F.gw; m < M; m += F.NGW) { const float ang = (float)pos[m] * inv; const double rev = (double)ang * 0.15915494309189535; const float fr = (float)(rev - rint(rev));
          f32x2 cs; cs.x = __builtin_amdgcn_cosf(fr); cs.y = __builtin_amdgcn_sinf(fr); *(GAS f32x2*)(rope + ((size_t)m * 64 + F.lane) * 2) = cs; } }
    LAS float* scr = (LAS float*)(F.lds + 65536 + F.wave * 8704);
    constexpr int I_W1 = 32 * 256, I_W2 = 128 * 64, I_NI = 32 * 168, I_NO = 32 * 64, I_DI = 32 * 192, I_DO = 32 * 64, I_C1 = 64 * 8, I_C2 = 4 * 4;
    constexpr int NITEMS = 4 * I_W1 + 4 * I_W2 + 2 * (I_NI + I_NO + I_DI + I_DO) + 4 * I_C1 + 4 * I_C2;
    for (int it = F.gw; it < NITEMS; it += F.NGW) {
        int r = it; const float* W; bf16* WT; int K, N, nblk;
        if (r < 4 * I_W1) { const int l = r / I_W1; r -= l * I_W1; W = inp(F, 7) + (size_t)l * DM * DFF; WT = (bf16*)(ws + WS_W1T) + (size_t)l * DFF * DM; K = DM; N = DFF; nblk = 256; }
        else if ((r -= 4 * I_W1) < 4 * I_W2) { const int l = r / I_W2; r -= l * I_W2; W = inp(F, 8) + (size_t)l * DFF * DM; WT = (bf16*)(ws + WS_W2T) + (size_t)l * DM * DFF; K = DFF; N = DM; nblk = 64; }
        else if ((r -= 4 * I_W2) < 2 * I_NI) { const int j = r / I_NI; r -= j * I_NI; W = inp(F, 9) + (size_t)j * DM * NSA_IN; WT = (bf16*)(ws + WS_NWIN) + (size_t)j * NSA_INP * DM; K = DM; N = NSA_IN; nblk = 168; }
        else if ((r -= 2 * I_NI) < 2 * I_NO) { const int j = r / I_NO; r -= j * I_NO; W = inp(F, 10) + (size_t)j * DM * DM; WT = (bf16*)(ws + WS_NWOUT) + (size_t)j * DM * DM; K = DM; N = DM; nblk = 64; }
        else if ((r -= 2 * I_NO) < 2 * I_DI) { const int j = r / I_DI; r -= j * I_DI; W = inp(F, 16) + (size_t)j * DM * DIFF_IN; WT = (bf16*)(ws + WS_DWIN) + (size_t)j * DIFF_IN * DM; K = DM; N = DIFF_IN; nblk = 192; }
        else if ((r -= 2 * I_DI) < 2 * I_DO) { const int j = r / I_DO; r -= j * I_DO; W = inp(F, 17) + (size_t)j * DM * DM; WT = (bf16*)(ws + WS_DWOUT) + (size_t)j * DM * DM; K = DM; N = DM; nblk = 64; }
        else if ((r -= 2 * I_DO) < 4 * I_C1) { const int q = r / I_C1; r -= q * I_C1; W = inp(F, 14) + (size_t)q * 4096 * 256; WT = (bf16*)(ws + WS_CW1) + (size_t)q * 256 * 4096; K = 4096; N = 256; nblk = 8; }
        else { r -= 4 * I_C1; const int q = r / I_C2; r -= q * I_C2; W = inp(F, 15) + (size_t)q * 256 * 128; WT = (bf16*)(ws + WS_CW2) + (size_t)q * 128 * 256; K = 256; N = 128; nblk = 4; }
        tr_item(W, K, N, WT, scr, r / nblk, r % nblk, F.lane);
    }
}

DEVI void p1_mod(const Ctx& F, unsigned char* ws) {
    const float* part = (const float*)(ws + WS_MODP); float* mod = (float*)(ws + WS_MOD); const float* ab = inp(F, 4);
    const int gt = (F.vcu * NWAVES + F.wave) * 64 + F.lane, GT = F.NGW * 64;
    for (int idx = gt; idx < 4 * NB * MODW; idx += GT) { const int l = idx / (NB * MODW), rem = idx - l * (NB * MODW), e = rem % MODW;
        float s = ab[l * MODW + e];
#pragma unroll
        for (int ks = 0; ks < 8; ++ks) s += part[((size_t)ks * 4 + l) * (NB * MODW) + rem];
        mod[idx] = s; }
}

DEVI void norm_pass(const Ctx& F, const float* x, const float* gamma, const float* sc, const float* sh, bf16* out) {
    for (int m = F.gw; m < M; m += F.NGW) {
        const int b = m >> 11;
        const GAS f32x4* xr = (const GAS f32x4*)(x + (size_t)m * DM) + F.lane;
        f32x4 v[8]; float ss = 0.f;
#pragma unroll
        for (int j = 0; j < 8; ++j) { v[j] = xr[64 * j]; ss += (v[j].x * v[j].x + v[j].y * v[j].y) + (v[j].z * v[j].z + v[j].w * v[j].w); }
        const float rstd = 1.f / sqrtf(wave_sum(ss) * (1.f / DM) + EPS);
        GAS u32x2* o8 = (GAS u32x2*)(out + (size_t)m * DM) + F.lane;
#pragma unroll
        for (int j = 0; j < 8; ++j) { const int c = 4 * F.lane + 256 * j;
            const f32x4 g = *(const GAS f32x4*)(gamma + c), s1 = *(const GAS f32x4*)(sc + (size_t)b * MODW + c), s0 = *(const GAS f32x4*)(sh + (size_t)b * MODW + c);
            const f32x4 y = (v[j] * rstd) * g * (s1 + 1.f) + s0;
            u32x2 w; w.x = pk2(y.x, y.y); w.y = pk2(y.z, y.w); o8[64 * j] = w; }
    }
}

DEVI void normrope16(v4u a, v4u b, const float* gamma, int c, const f32x4 (&cs)[4], v4u& oa, v4u& ob) {
    float x1[8], x2[8];
    x1[0] = bflo(a.x); x1[1] = bfhi(a.x); x1[2] = bflo(a.y); x1[3] = bfhi(a.y); x1[4] = bflo(a.z); x1[5] = bfhi(a.z); x1[6] = bflo(a.w); x1[7] = bfhi(a.w);
    x2[0] = bflo(b.x); x2[1] = bfhi(b.x); x2[2] = bflo(b.y); x2[3] = bfhi(b.y); x2[4] = bflo(b.z); x2[5] = bfhi(b.z); x2[6] = bflo(b.w); x2[7] = bfhi(b.w);
    float ss = 0.f;
#pragma unroll
    for (int i = 0; i < 8; ++i) ss += x1[i] * x1[i] + x2[i] * x2[i];
    ss += __shfl_xor(ss, 1); ss += __shfl_xor(ss, 2); ss += __shfl_xor(ss, 4);
    const float rstd = 1.f / sqrtf(ss * (1.f / 128.f) + EPS);
    const f32x4 g1a = *(const GAS f32x4*)(gamma + 8 * c), g1b = *(const GAS f32x4*)(gamma + 8 * c + 4), g2a = *(const GAS f32x4*)(gamma + 64 + 8 * c), g2b = *(const GAS f32x4*)(gamma + 64 + 8 * c + 4);
    float o1[8], o2[8];
#pragma unroll
    for (int i = 0; i < 8; ++i) { const float g1 = i < 4 ? g1a[i & 3] : g1b[i & 3], g2 = i < 4 ? g2a[i & 3] : g2b[i & 3];
        const float y1 = x1[i] * rstd * g1, y2 = x2[i] * rstd * g2, co = cs[i >> 1][(i & 1) * 2], si = cs[i >> 1][(i & 1) * 2 + 1];
        o1[i] = y1 * co - y2 * si; o2[i] = y2 * co + y1 * si; }
    oa.x = pk2(o1[0], o1[1]); oa.y = pk2(o1[2], o1[3]); oa.z = pk2(o1[4], o1[5]); oa.w = pk2(o1[6], o1[7]);
    ob.x = pk2(o2[0], o2[1]); ob.y = pk2(o2[2], o2[3]); ob.z = pk2(o2[4], o2[5]); ob.w = pk2(o2[6], o2[7]);
}

DEVI void nsa_post(const Ctx& F, unsigned char* ws, int j) {
    const bf16* raw = (const bf16*)(ws + WS_RAW); const float* rope = (const float*)(ws + WS_ROPE);
    bf16* qhm = (bf16*)(ws + WS_QHM); bf16* ka = (bf16*)(ws + WS_KA); float* gates = (float*)(ws + WS_GATES);
    const float* qg = inp(F, 11) + j * 128; const float* kg = inp(F, 12) + j * 384;
    const int sub = F.lane >> 3, c = F.lane & 7;
    for (int m = F.gw; m < M; m += F.NGW) {
        const int b = m >> 11, t = m & 2047;
        const bf16* rr = raw + (size_t)m * NSA_INP;
        f32x4 cs[4];
#pragma unroll
        for (int i = 0; i < 4; ++i) cs[i] = *(const GAS f32x4*)(rope + (size_t)m * 128 + 16 * c + 4 * i);
#pragma unroll
        for (int it = 0; it < 4; ++it) {
            int col; const float* gamma; bf16* dst;
            if (it < 2) { const int h = it * 8 + sub; col = h * 128; gamma = qg; dst = qhm + ((size_t)(b * 16 + h) * T + t) * 128; }
            else if (it == 2) { const int g = sub & 3, w = sub >> 2; col = (w ? 4096 : 3072) + g * 128; gamma = kg + (w ? 256 : 128); dst = ka + (size_t)w * (8 * MiB) + ((size_t)(b * 4 + g) * T + t) * 128; }
            else { const int g = sub & 3, w = sub >> 2; col = (w ? 4608 : 3584) + g * 128; gamma = qg; dst = ka + (size_t)(2 + w) * (8 * MiB) + ((size_t)(b * 4 + g) * T + t) * 128; }
            const v4u a = *(const GAS v4u*)(rr + col + 8 * c), bb = *(const GAS v4u*)(rr + col + 64 + 8 * c);
            v4u oa = a, ob = bb;
            if (it < 3) normrope16(a, bb, gamma, c, cs, oa, ob);
            *(GAS v4u*)(dst + 8 * c) = oa; *(GAS v4u*)(dst + 64 + 8 * c) = ob;
        }
        if (F.lane < 48) { const float gv = __uint_as_float((unsigned)rr[5120 + F.lane] << 16); gates[(size_t)m * 48 + F.lane] = 1.f / (1.f + expf(-gv)); }
    }
}
DEVI void diff_post(const Ctx& F, unsigned char* ws, int j) {
    const bf16* raw = (const bf16*)(ws + WS_RAW); const float* rope = (const float*)(ws + WS_ROPE);
    bf16* qhm = (bf16*)(ws + WS_QHM); bf16* ka = (bf16*)(ws + WS_KA); bf16* va = (bf16*)(ws + WS_VA);
    const float* qg = inp(F, 18) + j * 128; const float* kg = inp(F, 19) + j * 128;
    const int sub = F.lane >> 3, c = F.lane & 7;
    for (int m = F.gw; m < M; m += F.NGW) {
        const int b = m >> 11, t = m & 2047;
        const bf16* rr = raw + (size_t)m * DIFF_IN;
        f32x4 cs[4];
#pragma unroll
        for (int i = 0; i < 4; ++i) cs[i] = *(const GAS f32x4*)(rope + (size_t)m * 128 + 16 * c + 4 * i);
#pragma unroll
        for (int it = 0; it < 6; ++it) {
            const int hv = (it & 1) * 8 + sub, col = (it >> 1) * 2048 + hv * 128;
            bf16* dst = (it < 2 ? qhm : (it < 4 ? ka : va)) + ((size_t)(b * 16 + hv) * T + t) * 128;
            const float* gamma = it < 2 ? qg : kg;
            const v4u a = *(const GAS v4u*)(rr + col + 8 * c), bb = *(const GAS v4u*)(rr + col + 64 + 8 * c);
            v4u oa = a, ob = bb;
            if (it < 4) normrope16(a, bb, gamma, c, cs, oa, ob);
            *(GAS v4u*)(dst + 8 * c) = oa; *(GAS v4u*)(dst + 64 + 8 * c) = ob;
        }
    }
}

DEVI bf16x8 add_pos8(v4u a, f32x4 p0, f32x4 p1) {
    v4u o; o.x = pk2(bflo(a.x) + p0.x, bfhi(a.x) + p0.y); o.y = pk2(bflo(a.y) + p0.z, bfhi(a.y) + p0.w); o.z = pk2(bflo(a.z) + p1.x, bfhi(a.z) + p1.y); o.w = pk2(bflo(a.w) + p1.z, bfhi(a.w) + p1.w);
    return __builtin_bit_cast(bf16x8, o);
}
DEVI void compress_unit(const Ctx& F, unsigned char* ws, int j, int u) {
    const int kv = u >> 7, b = (u >> 4) & 7, g = (u >> 2) & 3, n0 = (u & 3) * 32;
    const int lane = F.lane, w = F.wave, r = lane & 31, hi = lane >> 5;
    const bf16* raw = (const bf16*)(ws + WS_RAW);
    const float* pos = inp(F, 13) + (size_t)(j * 2 + kv) * 4096;
    const bf16* W1t = (const bf16*)(ws + WS_CW1) + (size_t)(j * 2 + kv) * 256 * 4096;
    const bf16* W2t = (const bf16*)(ws + WS_CW2) + (size_t)(j * 2 + kv) * 128 * 256;
    LAS bf16* hidL = (LAS bf16*)(F.lds);
    LAS float* outL = (LAS float*)(F.lds + 32768);
    const int n = n0 + r; const bool nvalid = n <= 126;
    const bf16* arow = raw + (size_t)(b * T + 16 * (nvalid ? n : 0)) * NSA_INP + 2048 + kv * 512 + g * 128 + 8 * hi;
    const bf16* brow = W1t + (size_t)(32 * w + r) * 4096 + 8 * hi;
    const float* prow = pos + 8 * hi;
    f32x16 acc = {};
    for (int l = 0; l < 32; ++l) {
#pragma unroll
        for (int d0 = 0; d0 < 128; d0 += 16) {
            const v4u araw = *(const GAS v4u*)(arow + (size_t)l * NSA_INP + d0);
            const f32x4 p0 = *(const GAS f32x4*)(prow + l * 128 + d0), p1 = *(const GAS f32x4*)(prow + l * 128 + d0 + 4);
            bf16x8 a = add_pos8(araw, p0, p1); if (!nvalid) a = (bf16x8){0, 0, 0, 0, 0, 0, 0, 0};
            const bf16x8 bb = *(const GAS bf16x8*)(brow + l * 128 + d0);
            acc = mfma32(a, bb, acc);
        }
    }
#pragma unroll
    for (int rg = 0; rg < 16; ++rg) { const float v = acc[rg]; hidL[crow(rg, hi) * 264 + 32 * w + r] = (bf16)f2bf(v / (1.f + expf(-v))); }
    __syncthreads();
    if (w < 4) {
        f32x16 a2 = {};
        const bf16* b2 = W2t + (size_t)(32 * w + r) * 256 + 8 * hi;
#pragma unroll
        for (int k0 = 0; k0 < 256; k0 += 16) { const bf16x8 a = *(const LAS bf16x8*)(hidL + r * 264 + k0 + 8 * hi); const bf16x8 bb = *(const GAS bf16x8*)(b2 + k0); a2 = mfma32(a, bb, a2); }
#pragma unroll
        for (int rg = 0; rg < 16; ++rg) outL[crow(rg, hi) * 132 + 32 * w + r] = a2[rg];
    }
    __syncthreads();
    if (kv == 0) {
        if (F.tid < 256) { const int row = F.tid >> 3, c = F.tid & 7, nn = n0 + row;
            bf16* dst = (bf16*)(ws + WS_KCMP) + ((size_t)(b * 4 + g) * 128 + nn) * 128;
            v4u oa = {0u, 0u, 0u, 0u}, ob = oa;
            float x1[8], x2[8]; float ss = 0.f;
#pragma unroll
            for (int i = 0; i < 8; ++i) { x1[i] = outL[row * 132 + 8 * c + i]; x2[i] = outL[row * 132 + 64 + 8 * c + i]; ss += x1[i] * x1[i] + x2[i] * x2[i]; }
            ss += __shfl_xor(ss, 1); ss += __shfl_xor(ss, 2); ss += __shfl_xor(ss, 4);
            if (nn <= 126) {
                const float rstd = 1.f / sqrtf(ss * (1.f / 128.f) + EPS);
                const float* gamma = inp(F, 12) + j * 384;
                const float* rp = (const float*)(ws + WS_ROPE) + ((size_t)(b * T + 16 * nn + 31) * 64 + 8 * c) * 2;
                float o1[8], o2[8];
#pragma unroll
                for (int i = 0; i < 8; ++i) { const float y1 = x1[i] * rstd * gamma[8 * c + i], y2 = x2[i] * rstd * gamma[64 + 8 * c + i], co = rp[2 * i], si = rp[2 * i + 1];
                    o1[i] = y1 * co - y2 * si; o2[i] = y2 * co + y1 * si; }
                oa.x = pk2(o1[0], o1[1]); oa.y = pk2(o1[2], o1[3]); oa.z = pk2(o1[4], o1[5]); oa.w = pk2(o1[6], o1[7]);
                ob.x = pk2(o2[0], o2[1]); ob.y = pk2(o2[2], o2[3]); ob.z = pk2(o2[4], o2[5]); ob.w = pk2(o2[6], o2[7]);
            }
            *(GAS v4u*)(dst + 8 * c) = oa; *(GAS v4u*)(dst + 64 + 8 * c) = ob; }
    } else {
        const int d = F.tid >> 2, nc = F.tid & 3;
        bf16* dst = (bf16*)(ws + WS_VCMP) + ((size_t)(b * 4 + g) * 128 + d) * 128 + n0 + 8 * nc;
        float v[8];
#pragma unroll
        for (int i = 0; i < 8; ++i) v[i] = (n0 + 8 * nc + i <= 126) ? outL[(8 * nc + i) * 132 + d] : 0.f;
        v4u o; o.x = pk2(v[0], v[1]); o.y = pk2(v[2], v[3]); o.z = pk2(v[4], v[5]); o.w = pk2(v[6], v[7]);
        *(GAS v4u*)dst = o;
    }
    __syncthreads();
}

DEVI void cmpattn_unit(const Ctx& F, unsigned char* ws, int u) {
    const int b = u >> 8, g = (u >> 6) & 3, t0 = (u & 63) * 32;
    const int lane = F.lane, w = F.wave, r = lane & 31, hi = lane >> 5, hl = w >> 1;
    LAS float* SL = (LAS float*)(F.lds);
    LAS bf16* PL = (LAS bf16*)(F.lds + 67584);
    const bf16* qhm = (const bf16*)(ws + WS_QHM); const bf16* kcmp = (const bf16*)(ws + WS_KCMP); const bf16* vcmp = (const bf16*)(ws + WS_VCMP);
    { const bf16* qrow = qhm + ((size_t)(b * 16 + g * 4 + hl) * T + t0 + r) * 128 + 8 * hi;
#pragma unroll
      for (int kk = 0; kk < 2; ++kk) { const int kt = (w & 1) * 2 + kk;
          const bf16* krow = kcmp + ((size_t)(b * 4 + g) * 128 + kt * 32 + r) * 128 + 8 * hi;
          f32x16 acc = {};
#pragma unroll
          for (int d0 = 0; d0 < 8; ++d0) acc = mfma32(*(const GAS bf16x8*)(qrow + d0 * 16), *(const GAS bf16x8*)(krow + d0 * 16), acc);
#pragma unroll
          for (int rg = 0; rg < 16; ++rg) SL[(hl * 32 + crow(rg, hi)) * 132 + kt * 32 + r] = acc[rg]; } }
    __syncthreads();
    { const int row = F.tid >> 2, part = F.tid & 3, t = t0 + (row & 31), nmax = t >= 31 ? ((t - 31) >> 4) : -1;
      float v[32]; float mx = -__builtin_inff();
#pragma unroll
      for (int i = 0; i < 32; ++i) { const int n = part * 32 + i; const float s = SL[row * 132 + n] * fa::SCALE; v[i] = n <= nmax ? s : -__builtin_inff(); mx = fmaxf(mx, v[i]); }
      mx = fmaxf(mx, __shfl_xor(mx, 1)); mx = fmaxf(mx, __shfl_xor(mx, 2));
      float sum = 0.f;
#pragma unroll
      for (int i = 0; i < 32; ++i) { const int n = part * 32 + i; v[i] = n <= nmax ? expf(v[i] - mx) : 0.f; sum += v[i]; }
      sum += __shfl_xor(sum, 1); sum += __shfl_xor(sum, 2);
      const float inv = sum > 0.f ? 1.f / sum : 0.f;
#pragma unroll
      for (int i = 0; i < 32; ++i) { const int n = part * 32 + i; const float p = v[i] * inv; SL[row * 132 + n] = p; PL[row * 136 + n] = (bf16)f2bf(p); } }
    __syncthreads();
    { const int s = lane & 31, qa = 2 * w + hi;
#pragma unroll
      for (int rep = 0; rep < 2; ++rep) { const int qi = qa + 16 * rep, t = t0 + qi, tb = t >> 6;
          float imp = 0.f;
#pragma unroll
          for (int h4 = 0; h4 < 4; ++h4) { const LAS float* p = SL + (h4 * 32 + qi) * 132 + 4 * s;
              imp += (s > 0 ? p[-1] : 0.f) + 2.f * p[0] + 2.f * p[1] + 2.f * p[2] + p[3]; }
          const bool forced = (s == 0) || (s == tb) || (s == tb - 1), valid = s <= tb;
          const float val = forced ? 1e30f : (valid ? imp : -1e30f);
          int rank = 0;
#pragma unroll
          for (int s2 = 0; s2 < 32; ++s2) { const float o = __shfl(val, (lane & 32) + s2); rank += (o > val || (o == val && s2 < s)) ? 1 : 0; }
          const unsigned long long bal = __ballot(rank < 16);
          if (s == 0) ((unsigned*)(ws + WS_SEL))[(size_t)(b * 4 + g) * T + t] = (unsigned)(bal >> (lane & 32)); } }
    { bf16* ocmp = (bf16*)(ws + WS_O0);
#pragma unroll
      for (int kk = 0; kk < 2; ++kk) { const int dt = (w & 1) * 2 + kk;
          const bf16* vrow = vcmp + ((size_t)(b * 4 + g) * 128 + dt * 32 + r) * 128 + 8 * hi;
          f32x16 acc = {};
#pragma unroll
          for (int k0 = 0; k0 < 8; ++k0) acc = mfma32(*(const LAS bf16x8*)(PL + (hl * 32 + r) * 136 + k0 * 16 + 8 * hi), *(const GAS bf16x8*)(vrow + k0 * 16), acc);
#pragma unroll
          for (int rg = 0; rg < 16; ++rg) ocmp[(size_t)(b * T + t0 + crow(rg, hi)) * DM + (g * 4 + hl) * 128 + dt * 32 + r] = (bf16)f2bf(acc[rg]); } }
    __syncthreads();
}

DEVI void nsa_combine(const Ctx& F, unsigned char* ws) {
    const bf16* o0 = (const bf16*)(ws + WS_O0); const bf16* o1 = o0 + (size_t)M * DM; const bf16* o2 = o1 + (size_t)M * DM; const float* gates = (const float*)(ws + WS_GATES); bf16* ao = (bf16*)(ws + WS_AO);
    const int gt = F.gw * 64 + F.lane, GT = F.NGW * 64;
    for (int idx = gt; idx < M * (DM / 8); idx += GT) { const int m = idx >> 8, col = (idx & 255) * 8, h = col >> 7;
        const float g0 = gates[(size_t)m * 48 + h], g1 = gates[(size_t)m * 48 + 16 + h], g2 = gates[(size_t)m * 48 + 32 + h];
        const size_t off = (size_t)m * DM + col;
        const v4u a = *(const GAS v4u*)(o0 + off), bb = *(const GAS v4u*)(o1 + off), cc = *(const GAS v4u*)(o2 + off);
        v4u o;
        o.x = pk2(g0 * bflo(a.x) + g1 * bflo(bb.x) + g2 * bflo(cc.x), g0 * bfhi(a.x) + g1 * bfhi(bb.x) + g2 * bfhi(cc.x));
        o.y = pk2(g0 * bflo(a.y) + g1 * bflo(bb.y) + g2 * bflo(cc.y), g0 * bfhi(a.y) + g1 * bfhi(bb.y) + g2 * bfhi(cc.y));
        o.z = pk2(g0 * bflo(a.z) + g1 * bflo(bb.z) + g2 * bflo(cc.z), g0 * bfhi(a.z) + g1 * bfhi(bb.z) + g2 * bfhi(cc.z));
        o.w = pk2(g0 * bflo(a.w) + g1 * bflo(bb.w) + g2 * bflo(cc.w), g0 * bfhi(a.w) + g1 * bfhi(bb.w) + g2 * bfhi(cc.w));
        *(GAS v4u*)(ao + off) = o; }
}
DEVI void diff_combine(const Ctx& F, unsigned char* ws, int j, int layer) {
    const bf16* oraw = (const bf16*)(ws + WS_O0); bf16* ao = (bf16*)(ws + WS_AO);
    const float* lp = inp(F, 20) + j * 512; const float* sg = inp(F, 21) + j * 256;
    const float lam_init = 0.8f - 0.6f * expf(-0.3f * (float)layer);
    const float s01 = wave_sum(lp[F.lane] * lp[128 + F.lane] + lp[64 + F.lane] * lp[192 + F.lane]);
    const float s23 = wave_sum(lp[256 + F.lane] * lp[384 + F.lane] + lp[320 + F.lane] * lp[448 + F.lane]);
    const float lam = expf(s01) - expf(s23) + lam_init;
    const float osc = 1.f - lam_init;
    const int l5 = F.lane & 31, e0 = l5 * 8;
    const f32x4 ga = *(const GAS f32x4*)(sg + e0), gb = *(const GAS f32x4*)(sg + e0 + 4);
    for (int pp = F.gw; pp < M * 4; pp += F.NGW) { const int mh = pp * 2 + (F.lane >> 5), m = mh >> 3, h = mh & 7;
        const v4u a = *(const GAS v4u*)(oraw + (size_t)m * 4096 + (2 * h) * 256 + e0), bb = *(const GAS v4u*)(oraw + (size_t)m * 4096 + (2 * h + 1) * 256 + e0);
        float o[8];
        o[0] = bflo(a.x) - lam * bflo(bb.x); o[1] = bfhi(a.x) - lam * bfhi(bb.x); o[2] = bflo(a.y) - lam * bflo(bb.y); o[3] = bfhi(a.y) - lam * bfhi(bb.y);
        o[4] = bflo(a.z) - lam * bflo(bb.z); o[5] = bfhi(a.z) - lam * bfhi(bb.z); o[6] = bflo(a.w) - lam * bflo(bb.w); o[7] = bfhi(a.w) - lam * bfhi(bb.w);
        float ss = 0.f;
#pragma unroll
        for (int i = 0; i < 8; ++i) ss += o[i] * o[i];
        ss += __shfl_xor(ss, 1); ss += __shfl_xor(ss, 2); ss += __shfl_xor(ss, 4); ss += __shfl_xor(ss, 8); ss += __shfl_xor(ss, 16);
        const float rs = osc / sqrtf(ss * (1.f / 256.f) + EPS);
        v4u w; w.x = pk2(o[0] * rs * ga.x, o[1] * rs * ga.y); w.y = pk2(o[2] * rs * ga.z, o[3] * rs * ga.w); w.z = pk2(o[4] * rs * gb.x, o[5] * rs * gb.y); w.w = pk2(o[6] * rs * gb.z, o[7] * rs * gb.w);
        *(GAS v4u*)(ao + (size_t)m * DM + h * 256 + e0) = w; }
}

typedef fa::BlockRef<bf16, bf16> FaRef;
struct FaItem { const bf16* Q; const bf16* K; const bf16* V; bf16* O; const unsigned* sel; int W, os, qb0, qb1; };
constexpr int FA_BIGW = 1 << 20;
DEVI FaItem fa_item(unsigned char* ws, bool nsa, int L) {
    FaItem it; const bf16* qhm = (const bf16*)(ws + WS_QHM); const bf16* ka = (const bf16*)(ws + WS_KA); bf16* o0 = (bf16*)(ws + WS_O0);
    if (nsa) {
        if (L < 512) { const int bh = L >> 2, x = L & 3, b = bh >> 4, h = bh & 15, bg = b * 4 + (h >> 2);
            it.Q = qhm + (size_t)bh * T * 128; it.K = ka + (size_t)bg * T * 128; it.V = ka + (size_t)2 * (8 * MiB) + (size_t)bg * T * 128;
            it.O = o0 + (size_t)M * DM + (size_t)b * T * DM + h * 128; it.sel = (const unsigned*)(ws + WS_SEL) + (size_t)bg * T; it.W = FA_BIGW; it.os = DM; it.qb0 = x; it.qb1 = 7 - x; }
        else { const int L2 = L - 512, bh = L2 / 7, x = L2 - bh * 7, b = bh >> 4, h = bh & 15, bg = b * 4 + (h >> 2);
            it.Q = qhm + (size_t)bh * T * 128; it.K = ka + (size_t)1 * (8 * MiB) + (size_t)bg * T * 128; it.V = ka + (size_t)3 * (8 * MiB) + (size_t)bg * T * 128;
            it.O = o0 + (size_t)2 * M * DM + (size_t)b * T * DM + h * 128; it.sel = nullptr; it.W = 512; it.os = DM;
            if (x < 6) { it.qb0 = 7 - x; it.qb1 = 7 - x; } else { it.qb0 = 0; it.qb1 = 1; } }
    } else { const int bhh = L >> 2, x = L & 3, b = bhh >> 5, hc = (bhh >> 1) & 15, half = bhh & 1;
        it.Q = qhm + (size_t)(b * 16 + hc) * T * 128; it.K = ka + (size_t)(b * 16 + hc) * T * 128; it.V = (const bf16*)(ws + WS_VA) + (size_t)((b * 8 + (hc >> 1)) * 2 + half) * T * 128;
        it.O = o0 + (size_t)b * T * 4096 + (hc * 2 + half) * 128; it.sel = nullptr; it.W = FA_BIGW; it.os = 4096; it.qb0 = x; it.qb1 = 7 - x; }
    return it;
}
DEVI FaRef fa_ref(const FaItem& it, int pass) {
    const int qb = pass ? it.qb1 : it.qb0; FaRef r;
    r.Q = it.Q + (size_t)qb * 256 * 128; r.K = it.K; r.V = it.V; r.O = it.O + (size_t)qb * 256 * it.os; r.sel = it.sel; r.P0 = qb * 256; r.W = it.W; r.os = it.os;
    return r;
}
struct FaNext { unsigned char* ws; bool nsa; int L, pass;
    DEVI FaRef operator()() const { int l = L, p = pass; asm volatile("" : "+s"(l), "+s"(p)); const FaItem it = fa_item(ws, nsa, l); return fa_ref(it, p); } };
struct FaOut { unsigned char* ws; bool nsa; int L, pass;
    DEVI fa::OutRef<bf16> operator()() const { int l = L, p = pass; asm volatile("" : "+s"(l), "+s"(p)); const FaItem it = fa_item(ws, nsa, l); const FaRef r = fa_ref(it, p); fa::OutRef<bf16> o; o.O = r.O; o.os = r.os; return o; } };
DEVI void flash_phase(const Ctx& F, unsigned char* ws, bool nsa) {
    const int total = nsa ? 1408 : 1024, stride = F.G;
    int L = F.bid; if (L >= total) return;
    int pass = 0;
    fa::Seam<bf16> S;
    { const FaItem it = fa_item(ws, nsa, L); const FaRef cur = fa_ref(it, 0); fa::causal_swa_prime<bf16, bf16>(cur, F.ldsg, S); }
    for (;;) {
        const FaItem it = fa_item(ws, nsa, L); const FaRef cur = fa_ref(it, pass);
        const bool more_pass = pass == 0 && it.qb1 != it.qb0, more_item = L + stride < total, last = !more_pass && !more_item;
        int Ln = L, passn = pass;
        if (more_pass) passn = 1; else if (more_item) { Ln = L + stride; passn = 0; }
        const FaNext nx{ws, nsa, Ln, passn}; const FaOut ox{ws, nsa, L, pass};
        fa::causal_swa_block<bf16, bf16, FaNext, FaOut>(cur, nx, ox, T, F.ldsg, S);
        if (last) break;
        L = Ln; pass = passn;
    }
}

constexpr int PH_STEP0 = 3, PH_PER_STEP = 7, NPH = PH_STEP0 + 8 * PH_PER_STEP;
struct Args { const float* in[22]; float* out; unsigned char* ws; int ph_lo, ph_hi; };
__global__ void __launch_bounds__(NWAVES * 64, 2) mk_fwd(Args args) {
    extern __shared__ __attribute__((aligned(16))) unsigned char lds[];
    Ctx F;
#define MKCTX() do { F.lds = (LAS unsigned char*)lds; F.ldsg = (char*)lds; F.tid = opaque_tid(); F.lane = F.tid & 63; F.wave = __builtin_amdgcn_readfirstlane(F.tid >> 6); \
        F.G = gridDim.x; F.bid = opaque_bid(); F.vcu = (F.G % 8 == 0) ? (F.bid % 8) * (F.G / 8) + F.bid / 8 : F.bid; F.gw = F.vcu * NWAVES + F.wave; F.NGW = F.G * NWAVES; } while (0)
    MKCTX();
    unsigned char* ws = args.ws;
    volatile LAS unsigned* MISC = (volatile LAS unsigned*)(F.lds + MISC_OFF);
    for (int u = F.tid; u < (LDS_BYTES - LDSCTL_OFF) / 4; u += NWAVES * 64) ((LAS unsigned*)(F.lds + LDSCTL_OFF))[u] = 0u;
    __syncthreads();
    if (F.tid == 0) {
#pragma unroll
        for (int k = 0; k < 22; ++k) ((LAS unsigned long long*)(F.lds + PTR_OFF))[k] = (unsigned long long)args.in[k]; }
    __syncthreads();
    const int lo = args.ph_lo, hi = args.ph_hi;
    const bool use_bar = (hi - lo) > 1;
    XcdBarrier bar; bar.bar = (unsigned*)(ws + WS_CTL) + CW_BAR; bar.x = 0; bar.st = nullptr;
    if (use_bar) bar = xcd_barrier_post((unsigned*)(ws + WS_CTL) + CW_BAR, MISC + 8);
#define IN(k) (lo <= (k) && (k) < hi)
#define SEAM(k) do { if (IN((k) + 1)) xcd_barrier(bar); } while (0)

    if (IN(0)) { MKCTX(); if (EN(0)) p0_prologue(F, ws); SEAM(0); }
    if (IN(1)) { MKCTX(); p1_mod(F, ws); SEAM(1); }
    if (IN(2)) { MKCTX(); const float* mod = (const float*)(ws + WS_MOD); norm_pass(F, inp(F, 0), inp(F, 5), mod + DM, mod, (bf16*)(ws + WS_H)); SEAM(2); }

    for (int s = 0; s < 8; ++s) {
        const int layer = s >> 1, half = s & 1, j = layer >> 1, pb = PH_STEP0 + s * PH_PER_STEP;
        const bool nsa = (layer & 1) == 0;
        const float* mod = (const float*)(ws + WS_MOD) + (size_t)layer * NB * MODW;
        if (IN(pb + 0)) { MKCTX();
            pg8::Gemm g; pg8::EpiStore E;
            if (half == 0) { g.A = (const bf16*)(ws + WS_H); g.M = M; g.K = DM; E.O = (bf16*)(ws + WS_RAW); E.act = 0;
                if (nsa) { g.Bt = (const bf16*)(ws + WS_NWIN) + (size_t)j * NSA_INP * DM; g.N = NSA_INP; E.ldc = NSA_INP; }
                else { g.Bt = (const bf16*)(ws + WS_DWIN) + (size_t)j * DIFF_IN * DM; g.N = DIFF_IN; E.ldc = DIFF_IN; } }
            else { g.A = (const bf16*)(ws + WS_H); g.Bt = (const bf16*)(ws + WS_W1T) + (size_t)layer * DFF * DM; g.M = M; g.N = DFF; g.K = DM; E.O = (bf16*)(ws + WS_HID); E.ldc = DFF; E.act = 1; }
            pg8::StaticOrder S; S.init(g.M, g.N, F.G, F.bid);
            if (EN(1)) pg8::gemm_phase<pg8::EpiStore, pg8::StaticOrder, true, true>(F.lds, g, S, E);
            SEAM(pb + 0);
        }
        if (half == 0) {
            if (IN(pb + 1)) { MKCTX();
                if (nsa) { if (EN(2)) nsa_post(F, ws, j); __syncthreads(); if (EN(3)) for (int u = F.vcu; u < 256; u += F.G) compress_unit(F, ws, j, u); }
                else if (EN(2)) diff_post(F, ws, j);
                SEAM(pb + 1);
            }
            if (nsa && IN(pb + 2)) { MKCTX(); if (EN(4)) for (int u = F.vcu; u < 2048; u += F.G) cmpattn_unit(F, ws, u); SEAM(pb + 2); }
            if (IN(pb + 3)) { MKCTX(); if (EN(5)) flash_phase(F, ws, nsa); SEAM(pb + 3); }
            if (IN(pb + 4)) { MKCTX(); if (EN(6)) { if (nsa) nsa_combine(F, ws); else diff_combine(F, ws, j, layer); } SEAM(pb + 4); }
        }
        if (IN(pb + 5)) { MKCTX();
            pg8::Gemm g; pg8::EpiResid E;
            g.M = M; g.N = DM; E.xout = args.out; E.gstride = MODW;
            if (half == 0) { g.A = (const bf16*)(ws + WS_AO); g.K = DM; g.Bt = (nsa ? (const bf16*)(ws + WS_NWOUT) : (const bf16*)(ws + WS_DWOUT)) + (size_t)j * DM * DM;
                E.xin = (layer == 0) ? inp(F, 0) : args.out; E.gate = mod + 2 * DM; }
            else { g.A = (const bf16*)(ws + WS_HID); g.K = DFF; g.Bt = (const bf16*)(ws + WS_W2T) + (size_t)layer * DM * DFF; E.xin = args.out; E.gate = mod + 5 * DM; }
            pg8::StaticOrder S; S.init(g.M, g.N, F.G, F.bid);
            if (EN(7)) pg8::gemm_phase<pg8::EpiResid, pg8::StaticOrder, true, true>(F.lds, g, S, E);
            SEAM(pb + 5);
        }
        if (IN(pb + 6) && s < 7) { MKCTX();
            if (half == 0) norm_pass(F, args.out, inp(F, 6) + layer * DM, mod + 4 * DM, mod + 3 * DM, (bf16*)(ws + WS_H));
            else { const float* modn = mod + (size_t)NB * MODW; norm_pass(F, args.out, inp(F, 5) + (layer + 1) * DM, modn + DM, modn, (bf16*)(ws + WS_H)); }
            SEAM(pb + 6);
        }
    }
#undef IN
#undef SEAM
}

static bool phase_exists(int k) {
    if (k < PH_STEP0) return true;
    const int s = (k - PH_STEP0) / PH_PER_STEP, slot = (k - PH_STEP0) % PH_PER_STEP, layer = s >> 1, half = s & 1;
    if (slot == 0 || slot == 5) return true;
    if (slot == 6) return s < 7;
    if (half == 1) return false;
    if (slot == 2) return (layer & 1) == 0;
    return true;
}

extern "C" void kernel_launch(void* const* d_in, const int* in_sizes, int n_in, void* d_out, int out_size, void* d_ws, size_t ws_size, hipStream_t stream) {
    static int grid = 0;
    if (grid == 0) {
        if (n_in != 22 || in_sizes[0] != M * DM || out_size != M * DM || ws_size < WS_END) { fprintf(stderr, "kernel_launch: unexpected shapes (n_in %d, in0 %d, out %d, ws %zu; need ws >= %zu); nothing launched\n", n_in, n_in > 0 ? in_sizes[0] : -1, out_size, ws_size, (size_t)WS_END); grid = -1; return; }
        int dev = 0, cus = 0, per_cu = 0;
        if (hipGetDevice(&dev) != hipSuccess || hipDeviceGetAttribute(&cus, hipDeviceAttributeMultiprocessorCount, dev) != hipSuccess) { fprintf(stderr, "kernel_launch: device query failed\n"); grid = -1; return; }
        if (hipFuncSetAttribute((const void*)mk_fwd, hipFuncAttributeMaxDynamicSharedMemorySize, LDS_BYTES) != hipSuccess) { fprintf(stderr, "kernel_launch: hipFuncSetAttribute failed\n"); grid = -1; return; }
        if (hipOccupancyMaxActiveBlocksPerMultiprocessor(&per_cu, (const void*)mk_fwd, NWAVES * 64, LDS_BYTES) != hipSuccess || per_cu < 1)
            fprintf(stderr, "kernel_launch: note: occupancy query reports %d workgroups per CU\n", per_cu);
        (void)hipGetLastError();
        grid = cus;
    }
    if (grid < 0) return;
    if (hipMemsetAsync((char*)d_ws + WS_CTL, 0, CTL_ZERO_BYTES, stream) != hipSuccess) { fprintf(stderr, "kernel_launch: memset failed\n"); return; }
    Args a{};
    for (int i = 0; i < 22; ++i) a.in[i] = (const float*)d_in[i];
    a.out = (float*)d_out; a.ws = (unsigned char*)d_ws;
#if MK_N_LAUNCHES == 1
    a.ph_lo = 0; a.ph_hi = NPH;
    hipLaunchKernelGGL(mk_fwd, dim3(grid), dim3(NWAVES * 64), LDS_BYTES, stream, a);
#else
    for (int k = 0; k < NPH; ++k) { if (!phase_exists(k)) continue; a.ph_lo = k; a.ph_hi = k + 1;
        hipLaunchKernelGGL(mk_fwd, dim3(grid), dim3(NWAVES * 64), LDS_BYTES, stream, a); }
#endif
    const hipError_t le = hipPeekAtLastError();
    if (le != hipSuccess) fprintf(stderr, "kernel_launch: launch failed: %s\n", hipGetErrorName(le));
}
```

```cpp
#include <hip/hip_runtime.h>
#include <cstdio>
#include <cstdint>
#ifndef MK_N_LAUNCHES
#define MK_N_LAUNCHES 1
#endif
#ifndef MK_NOSEL
#define MK_NOSEL 0
#endif
#ifndef MK_SP2A
#define MK_SP2A true
#endif
#ifndef MK_SP2B
#define MK_SP2B true
#endif
#ifndef MK_WINPROBE
#define MK_WINPROBE 0
#endif
#ifndef MK_CMPPROBE
#define MK_CMPPROBE 0
#endif
#ifndef MK_XBF16
#define MK_XBF16 1
#endif
#ifndef MK_HSPLIT
#define MK_HSPLIT 0
#endif
#ifndef MK_DUAL
#define MK_DUAL 1
#endif
#ifndef MK_DIS
#define MK_DIS 0
#endif
#ifndef MK_REP
#define MK_REP 0
#endif
#ifndef MK_NULLEPI
#define MK_NULLEPI 0
#endif
#ifndef MK_FUSEC
#define MK_FUSEC 1
#endif
#ifndef MK_WIDE
#define MK_WIDE 0
#endif
#ifndef MK_NTS
#define MK_NTS 0
#endif
#define ST16(p, v) do { if (MK_NTS) __builtin_nontemporal_store((v), (u32x4*)(p)); else *(u32x4*)(p) = (v); } while (0)
#ifndef MK_REPC
#define MK_REPC 2
#endif
#define REPN(bit) (((MK_REP >> (bit)) & 1) ? MK_REPC : 1)
#define EN(bit) (!((MK_DIS >> (bit)) & 1))

constexpr int DM = 2048, NB = 8, T = 2048, M = NB * T, DFF = 8192;
constexpr int NSA_IN = 5168, NSA_INP = 5376, DIFF_IN = 6144, MODW = 6 * DM;
constexpr float EPS = 1e-6f;
constexpr int NWAVES = 8;

constexpr size_t MiB = 1u << 20;
constexpr size_t WS_CTL = 0, CTL_ZERO_BYTES = 256 * 1024;
constexpr size_t WS_MODP = 1 * MiB;
constexpr size_t WS_MOD = 13 * MiB;
constexpr size_t WS_ROPE = 15 * MiB;
constexpr size_t WS_GATES = 23 * MiB;
constexpr size_t WS_GS = 1120 * MiB;
constexpr size_t WS_SSQ = 1121 * MiB;
constexpr size_t WS_SHW = 1122 * MiB;
constexpr size_t WS_SEL = 1444 * MiB;
constexpr size_t WS_KCMP = 27 * MiB;
constexpr size_t WS_VCMP = 28 * MiB;
constexpr size_t WS_CW2 = 29 * MiB;
constexpr size_t WS_CW1 = 30 * MiB;
constexpr size_t WS_W1T = 38 * MiB;
constexpr size_t WS_W2T = 166 * MiB;
constexpr size_t WS_NWIN = 294 * MiB;
constexpr size_t WS_NWOUT = 336 * MiB;
constexpr size_t WS_DWIN = 352 * MiB;
constexpr size_t WS_DWOUT = 400 * MiB;
constexpr size_t WS_H = 416 * MiB;
constexpr size_t WS_AO = 480 * MiB;
constexpr size_t WS_RAW = 544 * MiB;
constexpr size_t WS_QHM = 736 * MiB;
constexpr size_t WS_HID = 1124 * MiB;
constexpr size_t WS_KA = 800 * MiB;
constexpr size_t WS_VA = 864 * MiB;
constexpr size_t WS_O0 = 928 * MiB;
constexpr size_t WS_XB = 1380 * MiB;
constexpr size_t WS_GP = 1445 * MiB;
constexpr size_t WS_END = 1458 * MiB;

constexpr int CW_BAR = 4096;
constexpr int CW_WFLAG = 16384;

constexpr int LDS_RL = 131072, LDS_SL = 133120;
constexpr int LDSCTL_OFF = 143360, PTR_OFF = LDSCTL_OFF + 64, MISC_OFF = LDSCTL_OFF + 320, LDS_BYTES = 147456;

__device__ __forceinline__ const float* in_ptr(__attribute__((address_space(3))) unsigned char* lds, int k) { const __attribute__((address_space(3))) unsigned* p = (const __attribute__((address_space(3))) unsigned*)(lds + PTR_OFF) + 2 * k;
    const unsigned lo = __builtin_amdgcn_readfirstlane(p[0]), hi = __builtin_amdgcn_readfirstlane(p[1]); return (const float*)(((unsigned long long)hi << 32) | lo); }
__device__ __forceinline__ int opaque_tid(int wv) { unsigned m = ~0u; asm volatile("" : "+s"(m), "+s"(wv)); return wv * 64 + (int)__builtin_amdgcn_mbcnt_hi(m, __builtin_amdgcn_mbcnt_lo(m, 0u)); }
__device__ __forceinline__ int opaque_bid() { int b = blockIdx.x; asm volatile("" : "+s"(b)); return b; }
namespace pg8 {
#define PG8_LAS __attribute__((address_space(3)))
typedef unsigned short bf16_t;
typedef short bf16x8 __attribute__((ext_vector_type(8)));
typedef float f32x4 __attribute__((ext_vector_type(4)));
typedef unsigned u32x4 __attribute__((ext_vector_type(4)));
constexpr int BM = 256, BK = 64, HALF = 128, HTB = HALF * BK * 2  , STAGE_BYTES = 8 * HTB, NXCD = 8, WGM = 8;

__host__ __device__ __forceinline__ int lds_byte(int r, int c) { const int st = (r >> 4) * 2 + (c >> 5), rr = r & 15, cc = c & 31, ob = rr * 64 + cc * 2; return st * 1024 + (ob ^ (((ob >> 9) & 1) << 5)); }
__host__ __device__ __forceinline__ void stage_rc(int b, int& R, int& C) { const int st = b / 1024, sb = b % 1024, swz = sb ^ (((sb >> 9) & 1) << 5); R = (st >> 1) * 16 + swz / 64; C = (st & 1) * 32 + (swz % 64) / 2; }
__host__ __device__ __forceinline__ int perm32(int rho) { const int n = rho >> 4, i = rho & 15; return 8 * (i >> 2) + 4 * n + (i & 3); }

struct Unit { int pm, pn, ko; };
struct Gemm { const bf16_t* A; const bf16_t* Bt; int M, N, K, ld; };

struct StaticOrder {
    int nM, nN, nwg, G, c;
    __host__ __device__ void init(int M, int N, int G_, int c_) { nM = M / BM; nN = N / BM; nwg = nM * nN; G = G_; c = c_; }
    __host__ __device__ bool next(int i, Unit& u) const {
        const long L = (long)i * G + c; if (L >= nwg) return false;
        int wgid = (int)L; { const int q = nwg / NXCD, r = nwg % NXCD, xcd = wgid % NXCD, off = wgid / NXCD; wgid = (xcd < r ? xcd * (q + 1) : r * (q + 1) + (xcd - r) * q) + off; }
        const int nig = WGM * nN, gid = wgid / nig, fm = gid * WGM, gsz = (nM - fm) < WGM ? (nM - fm) : WGM;
        u.pm = fm + ((wgid % nig) % gsz); u.pn = (wgid % nig) / gsz; u.ko = 0; return true;
    }
    __device__ __forceinline__ void a_ready(const Unit&) const {}
    __device__ __forceinline__ void done(const Unit&) const {}
};
struct SplitKOrder {
    int nU, G, c, pn, kq;
    __host__ __device__ void init(int M, int pn_, int kq_, int G_, int c_) { nU = (M / BM) * 4; pn = pn_; kq = kq_; G = G_; c = c_; }
    __host__ __device__ bool next(int i, Unit& u) const { const int L = i * G + c; if (L >= nU) return false; u.pm = L >> 2; u.pn = pn; u.ko = (L & 3) * kq; return true; }
    __device__ __forceinline__ void a_ready(const Unit&) const {}
    __device__ __forceinline__ void done(const Unit&) const {}
};
__device__ __forceinline__ unsigned cvt_pk_bf16(float lo, float hi) { unsigned r; asm volatile("v_cvt_pk_bf16_f32 %0, %1, %2" : "=v"(r) : "v"(lo), "v"(hi)); return r; }
typedef float f32x2 __attribute__((ext_vector_type(2)));
typedef _Float16 f16x2_t __attribute__((ext_vector_type(2)));
__device__ __forceinline__ unsigned cvt_pk_f16(float lo, float hi) { f16x2_t h; h.x = (_Float16)lo; h.y = (_Float16)hi; return __builtin_bit_cast(unsigned, h); }
__device__ __forceinline__ float f16lo(unsigned w) { return (float)__builtin_bit_cast(f16x2_t, w).x; }
__device__ __forceinline__ float f16hi(unsigned w) { return (float)__builtin_bit_cast(f16x2_t, w).y; }
struct EpiPre { f32x4 sq; float bias; };
__device__ __forceinline__ void epi_prefetch(EpiPre& p, const unsigned char* ws, int site, int m0, int b0, const Unit& u, int tid) {
    p.sq = *(const f32x4*)((const float*)(ws + WS_SSQ) + (size_t)(m0 + u.pm * BM + (tid >> 1)) * 8 + 4 * (tid & 1));
    p.bias = ((const float*)(ws + WS_SHW))[((size_t)site * NB + ((m0 + u.pm * BM) >> 11)) * 8192 + u.pn * BM + (tid & 255)];
}
__device__ __forceinline__ void epi_rowstats(const EpiPre& p, PG8_LAS float* rl, int tid) {
    float s = (p.sq.x + p.sq.y) + (p.sq.z + p.sq.w); s += __shfl_xor(s, 1);
    if ((tid & 1) == 0) rl[tid >> 1] = 1.0f / sqrtf(s * (1.0f / 2048.0f) + 1e-6f);
    if (tid < 256) rl[256 + tid] = p.bias;
    asm volatile("s_waitcnt lgkmcnt(0)" ::: "memory"); __builtin_amdgcn_s_barrier(); asm volatile("" ::: "memory");
}
struct EpiStore {
    static constexpr bool PERM = true, AFTER_DRAIN = false, WIDE = MK_WIDE != 0;
    unsigned char* ws; PG8_LAS unsigned char* lds; int site, m0, b0, hrow0;
    typedef EpiPre Pre;
    __device__ __forceinline__ void prefetch(Pre& p, const Unit& u, int tid) const { epi_prefetch(p, ws, site, m0, b0, u, tid); }
    __device__ __forceinline__ void operator()(const f32x4 (&acc)[2][2][4][2], const Unit& u, int wr, int wc, int fr, int fq, const Pre& p) const {
        asm volatile("" : "+v"(fr), "+v"(fq), "+s"(wr), "+s"(wc));
        PG8_LAS float* rl = (PG8_LAS float*)(lds + LDS_RL);
        epi_rowstats(p, rl, (wr * 4 + wc) * 64 + fq * 16 + fr);
        bf16_t* O = (bf16_t*)(ws + WS_HID);
        f32x4 bv[2][2];
        if constexpr (WIDE) {
            const int colw = wc * 64 + 8 * fq;
#pragma unroll
            for (int bj = 0; bj < 2; ++bj)
#pragma unroll
                for (int n = 0; n < 2; ++n) bv[bj][n] = *(const PG8_LAS f32x4*)(rl + 256 + colw + bj * 32 + 4 * n);
            const int hiF = fr >> 3, fr7 = fr & 7;
            bf16_t* base = O + (size_t)(hrow0 + u.pm * BM + wr * 64 + fr7) * DFF + u.pn * BM + wc * 64 + hiF * 32 + 8 * fq;
#pragma unroll
            for (int ai = 0; ai < 2; ++ai)
#pragma unroll
                for (int m = 0; m < 4; ++m) { const float rs = rl[ai * HALF + wr * 64 + m * 16 + fr]; u32x4 w[2];
#pragma unroll
                    for (int bj = 0; bj < 2; ++bj) { f32x4 v0 = acc[ai][bj][m][0] * rs + bv[bj][0], v1 = acc[ai][bj][m][1] * rs + bv[bj][1];
                        v0 = __builtin_elementwise_max(v0, (f32x4){0.f, 0.f, 0.f, 0.f}); v1 = __builtin_elementwise_max(v1, (f32x4){0.f, 0.f, 0.f, 0.f}); v0 = v0 * v0; v1 = v1 * v1;
                        w[bj].x = cvt_pk_bf16(v0[0], v0[1]); w[bj].y = cvt_pk_bf16(v0[2], v0[3]); w[bj].z = cvt_pk_bf16(v1[0], v1[1]); w[bj].w = cvt_pk_bf16(v1[2], v1[3]); }
                    u32x4 snd, rcv;
#pragma unroll
                    for (int e = 0; e < 4; ++e) { snd[e] = hiF ? w[0][e] : w[1][e]; rcv[e] = (unsigned)__builtin_amdgcn_update_dpp(0, (int)snd[e], 0x128, 0xf, 0xf, false); }
                    bf16_t* rowp = base + (size_t)(ai * HALF + m * 16) * DFF;
                    { const u32x4 sa_ = hiF ? rcv : w[0]; ST16(rowp, sa_); }
                    { const u32x4 sb_ = hiF ? w[1] : rcv; ST16(rowp + (size_t)8 * DFF, sb_); } }
        } else {
        const int row0 = hrow0 + u.pm * BM + wr * 64 + fr, col0 = u.pn * BM + wc * 32 + 8 * fq;
#pragma unroll
        for (int bj = 0; bj < 2; ++bj)
#pragma unroll
            for (int n = 0; n < 2; ++n) bv[bj][n] = *(const PG8_LAS f32x4*)(rl + 256 + wc * 32 + 8 * fq + bj * HALF + 4 * n);
#pragma unroll
        for (int ai = 0; ai < 2; ++ai)
#pragma unroll
            for (int m = 0; m < 4; ++m) { bf16_t* rowp = O + (size_t)(row0 + ai * HALF + m * 16) * DFF + col0; const float rs = rl[ai * HALF + wr * 64 + m * 16 + fr];
#pragma unroll
                for (int bj = 0; bj < 2; ++bj) { f32x4 v0 = acc[ai][bj][m][0] * rs + bv[bj][0], v1 = acc[ai][bj][m][1] * rs + bv[bj][1];
                    v0 = __builtin_elementwise_max(v0, (f32x4){0.f, 0.f, 0.f, 0.f}); v1 = __builtin_elementwise_max(v1, (f32x4){0.f, 0.f, 0.f, 0.f}); v0 = v0 * v0; v1 = v1 * v1;
                    u32x4 w; w.x = cvt_pk_bf16(v0[0], v0[1]); w.y = cvt_pk_bf16(v0[2], v0[3]); w.z = cvt_pk_bf16(v1[0], v1[1]); w.w = cvt_pk_bf16(v1[2], v1[3]);
                    ST16(rowp + bj * HALF, w); } }
        }
    }
};
struct EpiQKV {
    static constexpr bool PERM = true, AFTER_DRAIN = false, WIDE = false;
    unsigned char* ws; PG8_LAS unsigned char* lds; int site, j, nsa, m0, b0;
    typedef EpiPre Pre;
    __device__ __forceinline__ void prefetch(Pre& p, const Unit& u, int tid) const { epi_prefetch(p, ws, site, m0, b0, u, tid); }
    __device__ __forceinline__ void operator()(const f32x4 (&acc)[2][2][4][2], const Unit& u, int wr, int wc, int fr, int fq, const Pre& p) const {
        asm volatile("" : "+v"(fr), "+v"(fq), "+s"(wr), "+s"(wc));
        typedef unsigned u32x2_t __attribute__((ext_vector_type(2)));
        PG8_LAS float* rl = (PG8_LAS float*)(lds + LDS_RL); PG8_LAS float* nl = (PG8_LAS float*)(lds + LDS_SL);
        epi_rowstats(p, rl, (wr * 4 + wc) * 64 + fq * 16 + fr);
        bf16_t* raw = (bf16_t*)(ws + WS_RAW); bf16_t* qhm = (bf16_t*)(ws + WS_QHM); bf16_t* ka = (bf16_t*)(ws + WS_KA); bf16_t* va = (bf16_t*)(ws + WS_VA);
        const unsigned* rope = (const unsigned*)(ws + WS_ROPE); float* gates = (float*)(ws + WS_GATES); const int ldc = nsa ? NSA_INP : DIFF_IN;
        const float* g_q = in_ptr(lds, nsa ? 11 : 18) + j * 128;
        const float* g_k1 = nsa ? in_ptr(lds, 12) + j * 384 + 128 : in_ptr(lds, 19) + j * 128;
        const float* g_k2 = nsa ? in_ptr(lds, 12) + j * 384 + 256 : g_k1;
        const int pn = u.pn; int mode, nh, hidx0; bf16_t* dst; const float* gamma;
        if (pn < 8) { mode = 1; nh = 16; hidx0 = 2 * pn; dst = qhm; gamma = g_q; }
        else if (nsa) {
            if (pn < 12) { mode = 0; nh = 0; hidx0 = 0; dst = raw; gamma = g_q; }
            else if (pn < 20) { const int w4 = (pn - 12) >> 1;
                mode = (w4 & 1) ? 2 : 1; nh = 4; hidx0 = 2 * ((pn - 12) & 1); dst = ka + (size_t)((w4 >> 1) + 2 * (w4 & 1)) * 8388608; gamma = (w4 >> 1) ? g_k2 : g_k1; }
            else { mode = 3; nh = 0; hidx0 = 0; dst = raw; gamma = g_q; }
        } else {
            if (pn < 16) { mode = 1; nh = 16; hidx0 = 2 * (pn - 8); dst = ka; gamma = g_k1; }
            else { mode = 2; nh = 16; hidx0 = 2 * (pn - 16); dst = va; gamma = g_q; }
        }
        const int rbase = m0 + u.pm * BM + wr * 64 + fr;
        f32x4 bv[2][2];
#pragma unroll
        for (int bj = 0; bj < 2; ++bj)
#pragma unroll
            for (int n = 0; n < 2; ++n) bv[bj][n] = *(const PG8_LAS f32x4*)(rl + 256 + wc * 32 + 8 * fq + bj * HALF + 4 * n);
        if (mode == 1) {
            const int Q = 4 * wc + fq;
            u32x4 ra[2], rb[2];
#define RC_LOAD(X, i) do { _Pragma("unroll") for (int mm = 0; mm < 2; ++mm) X[mm] = *(const u32x4*)(rope + (size_t)(rbase + ((i) >> 1) * HALF + (((i) & 1) * 2 + mm) * 16) * 64 + 4 * Q); } while (0)
            RC_LOAD(ra, 0);
#pragma unroll
            for (int ai = 0; ai < 2; ++ai)
#pragma unroll
                for (int m = 0; m < 4; ++m) { const int rloc = ai * HALF + wr * 64 + m * 16 + fr; const float rs = rl[rloc];
#pragma unroll
                    for (int bj = 0; bj < 2; ++bj) { const f32x4 a = acc[ai][bj][m][0] * rs + bv[bj][0], b = acc[ai][bj][m][1] * rs + bv[bj][1];
                        float q = (a[0] * a[0] + a[1] * a[1]) + (a[2] * a[2] + a[3] * a[3]) + (b[0] * b[0] + b[1] * b[1]) + (b[2] * b[2] + b[3] * b[3]);
                        q += __shfl_xor(q, 16); q += __shfl_xor(q, 32); if (fq == 0) nl[(rloc * 2 + bj) * 4 + wc] = q; } }
            asm volatile("s_waitcnt lgkmcnt(0)" ::: "memory"); __builtin_amdgcn_s_barrier(); asm volatile("" ::: "memory");
            const f32x4 g1 = *(const f32x4*)(gamma + 4 * Q), g2 = *(const f32x4*)(gamma + 64 + 4 * Q);
#define RC_DO(X, i) do { _Pragma("unroll") for (int mm = 0; mm < 2; ++mm) { const int ai = (i) >> 1, m = ((i) & 1) * 2 + mm, rloc = ai * HALF + wr * 64 + m * 16 + fr, row = rbase + ai * HALF + m * 16, b = row >> 11, t = row & 2047; const float rs = rl[rloc]; \
                const u32x4 cw = X[mm]; const f32x4 co = {f16lo(cw.x), f16lo(cw.y), f16lo(cw.z), f16lo(cw.w)}, si = {f16hi(cw.x), f16hi(cw.y), f16hi(cw.z), f16hi(cw.w)};     \
                _Pragma("unroll") for (int bj = 0; bj < 2; ++bj) { const f32x4 sq4 = *(const PG8_LAS f32x4*)(nl + (rloc * 2 + bj) * 4); \
                    const float rh = 1.0f / sqrtf(((sq4.x + sq4.y) + (sq4.z + sq4.w)) * (1.0f / 128.0f) + 1e-6f); \
                    const f32x4 y1 = (acc[ai][bj][m][0] * rs + bv[bj][0]) * rh * g1, y2 = (acc[ai][bj][m][1] * rs + bv[bj][1]) * rh * g2; \
                    const f32x4 o1 = y1 * co - y2 * si, o2 = y2 * co + y1 * si; \
                    bf16_t* dp = dst + ((size_t)(b * nh + hidx0 + bj) * 2048 + t) * 128 + ((fq & 1) ? 64 + 4 * (Q - 1) : 4 * Q); \
                    u32x2_t w1, w2; w1.x = cvt_pk_bf16(o1[0], o1[1]); w1.y = cvt_pk_bf16(o1[2], o1[3]); w2.x = cvt_pk_bf16(o2[0], o2[1]); w2.y = cvt_pk_bf16(o2[2], o2[3]); \
                    const auto sx_ = __builtin_amdgcn_permlane16_swap(w1.x, w2.x, false, false); const auto sy_ = __builtin_amdgcn_permlane16_swap(w1.y, w2.y, false, false);     \
                    u32x4 q4_; q4_.x = sx_[0]; q4_.y = sy_[0]; q4_.z = sx_[1]; q4_.w = sy_[1]; *(u32x4*)dp = q4_; } } } while (0)
#define RC_FENCE() asm volatile("" ::: "memory")
            RC_LOAD(rb, 1); RC_FENCE(); RC_DO(ra, 0); RC_FENCE();
            RC_LOAD(ra, 2); RC_FENCE(); RC_DO(rb, 1); RC_FENCE();
            RC_LOAD(rb, 3); RC_FENCE(); RC_DO(ra, 2); RC_FENCE();
            RC_DO(rb, 3);
#undef RC_LOAD
#undef RC_DO
#undef RC_FENCE
        } else {
#pragma unroll
            for (int ai = 0; ai < 2; ++ai)
#pragma unroll
                for (int m = 0; m < 4; ++m) { const int rloc = ai * HALF + wr * 64 + m * 16 + fr, row = rbase + ai * HALF + m * 16, b = row >> 11, t = row & 2047; const float rs = rl[rloc];
#pragma unroll
                    for (int bj = 0; bj < 2; ++bj) { const f32x4 v0 = acc[ai][bj][m][0] * rs + bv[bj][0], v1 = acc[ai][bj][m][1] * rs + bv[bj][1];
                        if (mode == 3) { const int c0 = bj * HALF + wc * 32 + 8 * fq;
                            if (c0 < 48) { f32x4 s0, s1;
#pragma unroll
                                for (int i = 0; i < 4; ++i) { s0[i] = 1.0f / (1.0f + __expf(-v0[i])); s1[i] = 1.0f / (1.0f + __expf(-v1[i])); }
#pragma unroll
                                for (int i = 0; i < 4; ++i) { const int ca = c0 + i, cb = c0 + 4 + i;
                                    gates[((size_t)row * 16 + (ca & 15)) * 4 + (ca >> 4)] = s0[i]; gates[((size_t)row * 16 + (cb & 15)) * 4 + (cb >> 4)] = s1[i]; } } }
                        else { u32x4 w; w.x = cvt_pk_bf16(v0[0], v0[1]); w.y = cvt_pk_bf16(v0[2], v0[3]); w.z = cvt_pk_bf16(v1[0], v1[1]); w.w = cvt_pk_bf16(v1[2], v1[3]);
                            bf16_t* dp = mode == 0 ? raw + (size_t)row * ldc + pn * BM + bj * HALF + wc * 32 + 8 * fq
                                                   : dst + ((size_t)(b * nh + hidx0 + bj) * 2048 + t) * 128 + wc * 32 + 8 * fq;
                            *(u32x4*)dp = w; } } }
        }
    }
};
struct EpiGatesP {
    static constexpr bool PERM = true, AFTER_DRAIN = false, WIDE = false;
    unsigned char* ws; int m0;
    struct Pre {};
    __device__ __forceinline__ void prefetch(Pre&, const Unit&, int) const {}
    __device__ __forceinline__ void operator()(const f32x4 (&acc)[2][2][4][2], const Unit& u, int wr, int wc, int fr, int fq, const Pre&) const {
        asm volatile("" : "+v"(fr), "+v"(fq), "+s"(wr), "+s"(wc));
        float* gp = (float*)(ws + WS_GP) + (size_t)(u.ko >> 9) * ((size_t)M * 48);
        const int c0 = wc * 32 + 8 * fq;
        if (c0 < 48) {
#pragma unroll
            for (int ai = 0; ai < 2; ++ai)
#pragma unroll
                for (int m = 0; m < 4; ++m) { float* rp_ = gp + (size_t)(m0 + u.pm * BM + ai * HALF + wr * 64 + m * 16 + fr) * 48 + c0;
                    *(f32x4*)rp_ = acc[ai][0][m][0]; *(f32x4*)(rp_ + 4) = acc[ai][0][m][1]; }
        }
    }
};
struct EpiNull { static constexpr bool PERM = true, AFTER_DRAIN = false, WIDE = false; struct Pre {}; __device__ __forceinline__ void prefetch(Pre&, const Unit&, int) const {}
    __device__ __forceinline__ void operator()(const f32x4 (&acc)[2][2][4][2], const Unit&, int, int, int, int, const Pre&) const {
#pragma unroll
        for (int a = 0; a < 2; ++a)
#pragma unroll
            for (int b = 0; b < 2; ++b)
#pragma unroll
                for (int m = 0; m < 4; ++m)
#pragma unroll
                    for (int n = 0; n < 2; ++n) asm volatile("" :: "v"(acc[a][b][m][n]));
    } };
template <bool FIRST_, bool EMIT_>
struct EpiResidT {
    static constexpr bool PERM = false, AFTER_DRAIN = false, WIDE = false;
    unsigned char* ws; float* xo; float* xo2; PG8_LAS unsigned char* lds; int s, m0, b0;
    struct Pre {};
    __device__ __forceinline__ void prefetch(Pre&, const Unit&, int) const {}
    __device__ __forceinline__ void operator()(const f32x4 (&acc)[2][2][4][2], const Unit& u, int wr, int wc, int fr, int fq, const Pre&) const {
        asm volatile("" : "+v"(fr), "+v"(fq), "+s"(wr), "+s"(wc));
        constexpr bool emit = EMIT_, first = FIRST_;
        const int layer = s >> 1, bat = (m0 + u.pm * BM) >> 11;
        bf16_t* xcar = (bf16_t*)(ws + WS_XB) + (size_t)m0 * 2048;
        const float* xin = (s == 0 ? in_ptr(lds, 0) : xo) + (size_t)m0 * 2048; float* xout = xo2 + (size_t)m0 * 2048; bf16_t* xg = (bf16_t*)(ws + WS_H) + (size_t)m0 * 2048;
        const float* gp = (const float*)(ws + WS_MOD) + ((size_t)layer * NB + bat) * MODW + ((s & 1) ? 5 : 2) * 2048;
        const float* gs = (const float*)(ws + WS_GS) + ((size_t)(s + 1) * NB + bat) * 2048;
        float* ssq = (float*)(ws + WS_SSQ) + (size_t)m0 * 8; PG8_LAS float* sl = (PG8_LAS float*)(lds + LDS_SL);
        const int col0 = u.pn * BM + wc * 32 + 4 * fq;
        f32x4 gv[2][2], sv[2][2];
#pragma unroll
        for (int bj = 0; bj < 2; ++bj)
#pragma unroll
            for (int n = 0; n < 2; ++n) { gv[bj][n] = *(const f32x4*)(gp + col0 + bj * HALF + n * 16); sv[bj][n] = emit ? *(const f32x4*)(gs + col0 + bj * HALF + n * 16) : (f32x4){0.f, 0.f, 0.f, 0.f}; }
        const int hiF = fr >> 3, fr7 = fr & 7;
        const size_t offx = (size_t)(u.pm * BM + wr * 64 + fr7) * 2048 + u.pn * BM + wc * 32 + 16 * hiF + 4 * fq;
        typedef unsigned u32x2_t __attribute__((ext_vector_type(2)));
        const size_t og_ = (size_t)(u.pm * BM + wr * 64 + fr7 + 8 * (fq & 1)) * 2048 + u.pn * BM + wc * 32 + 16 * hiF + 4 * (fq & ~1);
#define ROR8(x) __uint_as_float((unsigned)__builtin_amdgcn_update_dpp(0, (int)__float_as_uint(x), 0x128, 0xf, 0xf, false))
#define ROR8U(x) ((unsigned)__builtin_amdgcn_update_dpp(0, (int)(x), 0x128, 0xf, 0xf, false))
        f32x4 xa[2][2], xb[2][2], xc[2][2];
#define RES_LOAD(X, i) do { const size_t r_ = (size_t)(((i) >> 2) * HALF + ((i) & 3) * 16) * 2048, o_ = offx + r_; _Pragma("unroll") for (int bj = 0; bj < 2; ++bj) { \
        if (MK_XBF16 && !first) { X[bj][0] = __builtin_bit_cast(f32x4, *(const u32x4*)(xcar + og_ + r_ + bj * HALF)); }     \
        else { X[bj][0] = *(const f32x4*)(xin + o_ + bj * HALF); X[bj][1] = *(const f32x4*)(xin + o_ + bj * HALF + 8 * 2048); } } } while (0)
#define RES_DO(X, i) do { const int ai = (i) >> 2, m = (i) & 3, rloc = ai * HALF + wr * 64 + m * 16 + fr; const size_t o_ = offx + (size_t)(ai * HALF + m * 16) * 2048; float q = 0.f; \
        _Pragma("unroll") for (int bj = 0; bj < 2; ++bj) { f32x4 v1 = X[bj][0], v2 = (MK_XBF16 && !first) ? X[bj][0] : X[bj][1]; f32x4 snd, rcv; \
            if (MK_XBF16 && !first) { const u32x4 q_ = __builtin_bit_cast(u32x4, X[bj][0]); const auto ux_ = __builtin_amdgcn_permlane16_swap(q_.x, q_.z, false, false); const auto uy_ = __builtin_amdgcn_permlane16_swap(q_.y, q_.w, false, false); \
                v1 = (f32x4){f16lo(ux_[0]), f16hi(ux_[0]), f16lo(uy_[0]), f16hi(uy_[0])}; v2 = (f32x4){f16lo(ux_[1]), f16hi(ux_[1]), f16lo(uy_[1]), f16hi(uy_[1])}; } \
            _Pragma("unroll") for (int e = 0; e < 4; ++e) { snd[e] = hiF ? v1[e] : v2[e]; rcv[e] = ROR8(snd[e]); } \
            f32x4 x0, x1; _Pragma("unroll") for (int e = 0; e < 4; ++e) { x0[e] = hiF ? rcv[e] : v1[e]; x1[e] = hiF ? v2[e] : rcv[e]; }            \
            const f32x4 n0 = x0 + gv[bj][0] * acc[ai][bj][m][0], n1 = x1 + gv[bj][1] * acc[ai][bj][m][1]; \
            if (MK_XBF16 && emit) { u32x2_t c0, c1; c0.x = cvt_pk_f16(n0[0], n0[1]); c0.y = cvt_pk_f16(n0[2], n0[3]); c1.x = cvt_pk_f16(n1[0], n1[1]); c1.y = cvt_pk_f16(n1[2], n1[3]); \
                u32x2_t cs_, cr_; cs_.x = hiF ? c0.x : c1.x; cs_.y = hiF ? c0.y : c1.y; cr_.x = ROR8U(cs_.x); cr_.y = ROR8U(cs_.y); \
                u32x2_t d1, d2; d1.x = hiF ? cr_.x : c0.x; d1.y = hiF ? cr_.y : c0.y; d2.x = hiF ? c1.x : cr_.x; d2.y = hiF ? c1.y : cr_.y; \
                const auto cx_ = __builtin_amdgcn_permlane16_swap(d1.x, d2.x, false, false); const auto cy_ = __builtin_amdgcn_permlane16_swap(d1.y, d2.y, false, false); \
                u32x4 c4_; c4_.x = cx_[0]; c4_.y = cy_[0]; c4_.z = cx_[1]; c4_.w = cy_[1]; *(u32x4*)(xcar + og_ + (size_t)(ai * HALF + m * 16) * 2048 + bj * HALF) = c4_; }     \
            else { _Pragma("unroll") for (int e = 0; e < 4; ++e) { snd[e] = hiF ? n0[e] : n1[e]; rcv[e] = ROR8(snd[e]); } \
            f32x4 s1, s2; _Pragma("unroll") for (int e = 0; e < 4; ++e) { s1[e] = hiF ? rcv[e] : n0[e]; s2[e] = hiF ? n1[e] : rcv[e]; } \
            *(f32x4*)(xout + o_ + bj * HALF) = s1; *(f32x4*)(xout + o_ + bj * HALF + 8 * 2048) = s2; } \
            if (emit) { const f32x4 y0 = n0 * sv[bj][0], y1 = n1 * sv[bj][1]; u32x2_t w0, w1; w0.x = cvt_pk_bf16(y0[0], y0[1]); w0.y = cvt_pk_bf16(y0[2], y0[3]); w1.x = cvt_pk_bf16(y1[0], y1[1]); w1.y = cvt_pk_bf16(y1[2], y1[3]); \
                u32x2_t ws_, wr_; ws_.x = hiF ? w0.x : w1.x; ws_.y = hiF ? w0.y : w1.y; wr_.x = ROR8U(ws_.x); wr_.y = ROR8U(ws_.y); \
                u32x2_t t1, t2; t1.x = hiF ? wr_.x : w0.x; t1.y = hiF ? wr_.y : w0.y; t2.x = hiF ? w1.x : wr_.x; t2.y = hiF ? w1.y : wr_.y;            \
                const auto sx_ = __builtin_amdgcn_permlane16_swap(t1.x, t2.x, false, false); const auto sy_ = __builtin_amdgcn_permlane16_swap(t1.y, t2.y, false, false);     \
                u32x4 q4_; q4_.x = sx_[0]; q4_.y = sy_[0]; q4_.z = sx_[1]; q4_.w = sy_[1]; *(u32x4*)(xg + og_ + (size_t)(ai * HALF + m * 16) * 2048 + bj * HALF) = q4_; \
                q += (n0[0] * n0[0] + n0[1] * n0[1]) + (n0[2] * n0[2] + n0[3] * n0[3]) + (n1[0] * n1[0] + n1[1] * n1[1]) + (n1[2] * n1[2] + n1[3] * n1[3]); } } \
        if (emit) { q += __shfl_xor(q, 16); q += __shfl_xor(q, 32); if (fq == 0) sl[rloc * 4 + wc] = q; } } while (0)
#define RES_FENCE() asm volatile("" ::: "memory")
        RES_LOAD(xa, 0); RES_LOAD(xb, 1); RES_FENCE();
        RES_LOAD(xc, 2); RES_FENCE(); RES_DO(xa, 0); RES_FENCE();
        RES_LOAD(xa, 3); RES_FENCE(); RES_DO(xb, 1); RES_FENCE();
        RES_LOAD(xb, 4); RES_FENCE(); RES_DO(xc, 2); RES_FENCE();
        RES_LOAD(xc, 5); RES_FENCE(); RES_DO(xa, 3); RES_FENCE();
        RES_LOAD(xa, 6); RES_FENCE(); RES_DO(xb, 4); RES_FENCE();
        RES_LOAD(xb, 7); RES_FENCE(); RES_DO(xc, 5); RES_FENCE();
        RES_DO(xa, 6); RES_FENCE(); RES_DO(xb, 7);
#undef RES_LOAD
#undef RES_DO
#undef RES_FENCE
#undef ROR8
#undef ROR8U
        if (emit) { asm volatile("s_waitcnt lgkmcnt(0)" ::: "memory"); __builtin_amdgcn_s_barrier(); asm volatile("" ::: "memory");
            const int tid = (wr * 4 + wc) * 64 + fq * 16 + fr;
            if (tid < 256) { const f32x4 p = *(const PG8_LAS f32x4*)(sl + tid * 4); ssq[(size_t)(u.pm * BM + tid) * 8 + u.pn] = (p.x + p.y) + (p.z + p.w); } }
    }
};
template <class Epi, class Sched, bool ALIGN_EPI = false, bool SP2 = false>
__device__ __forceinline__ void gemm_phase(PG8_LAS unsigned char* lds, const Gemm g, const Sched& S, const Epi& E, const int wv) {
    const int tid = opaque_tid(wv), wid = __builtin_amdgcn_readfirstlane(tid >> 6), lane = tid & 63, wr = wid >> 2, wc = wid & 3, fr = lane & 15, fq = lane >> 4;
    const int K = g.ld, nt = g.K / BK;
    unsigned voffA[2], voffB[2];
#pragma unroll
    for (int i = 0; i < 2; ++i) { int R, C; stage_rc(tid * 16 + i * 8192, R, C); const int Rb = Epi::WIDE ? ((R >> 5) * 64 + perm32(R & 31)) : (Epi::PERM ? ((R & ~31) + perm32(R & 31)) : R);
        voffA[i] = (unsigned)(R * K + C) * 2u; voffB[i] = (unsigned)(Rb * K + C) * 2u; }
    const size_t kstep = (size_t)(BK * 2);
    const size_t hstep = (size_t)HALF * K * 2;
    const size_t tstep = 2 * hstep;
    const size_t hstepB = Epi::WIDE ? (size_t)32 * K * 2 : hstep;
    const unsigned ldsw = (unsigned)wid * 1024u;
    const int aoff = lds_byte(wr * 64 + fr, fq * 8), boff = lds_byte(wc * 32 + fr, fq * 8);
#define PG8_SA(b, h) (((b) * 2 + (h)) * HTB)
#define PG8_SB(b, h) ((4 + (b) * 2 + (h)) * HTB)
#define PG8_STAGE(bufoff, gbase, voff) do { _Pragma("unroll") for (int _i = 0; _i < 2; ++_i) \
        __builtin_amdgcn_global_load_lds((const unsigned*)((const char*)(gbase) + (voff)[_i]), (PG8_LAS unsigned*)(lds + (bufoff) + ldsw + _i * 8192), 16, 0, 0); } while (0)
#define PG8_LDA(dst, b, h) do { _Pragma("unroll") for (int m = 0; m < 4; ++m) _Pragma("unroll") for (int k = 0; k < 2; ++k) dst[m][k] = *(const PG8_LAS bf16x8*)(lds + PG8_SA(b, h) + aoff + m * 2048 + k * 1024); } while (0)
#define PG8_LDB(dst, b, h) do { _Pragma("unroll") for (int n = 0; n < 2; ++n) _Pragma("unroll") for (int k = 0; k < 2; ++k) dst[n][k] = *(const PG8_LAS bf16x8*)(lds + PG8_SB(b, h) + boff + n * 2048 + k * 1024); } while (0)
#define PG8_MMA(ai, bj, At, Bt) do { __builtin_amdgcn_s_setprio(1); _Pragma("unroll") for (int m = 0; m < 4; ++m) _Pragma("unroll") for (int n = 0; n < 2; ++n) _Pragma("unroll") for (int k = 0; k < 2; ++k) \
        acc[ai][bj][m][n] = __builtin_amdgcn_mfma_f32_16x16x32_bf16(Bt[n][k], At[m][k], acc[ai][bj][m][n], 0, 0, 0); __builtin_amdgcn_s_setprio(0); } while (0)
#define PG8_WAIT_V(n) asm volatile("s_waitcnt vmcnt(" #n ")" ::: "memory")
#define PG8_WAIT_L(n) asm volatile("s_waitcnt lgkmcnt(" #n ")" ::: "memory")
#define PG8_BAR __builtin_amdgcn_s_barrier()
#define PG8_SCHED __builtin_amdgcn_sched_barrier(0)
    Unit cur, nxt; int ui = 0; typename Epi::Pre pre;
    if (!S.next(0, cur)) return;
    f32x4 acc[2][2][4][2];
#pragma unroll
    for (int a = 0; a < 2; ++a)
#pragma unroll
        for (int b = 0; b < 2; ++b)
#pragma unroll
            for (int m = 0; m < 4; ++m)
#pragma unroll
                for (int n = 0; n < 2; ++n) acc[a][b][m][n] = (f32x4){0.f, 0.f, 0.f, 0.f};
    bf16x8 At[4][2], B0[2][2], B1[2][2];
    const char* cA = (const char*)g.A + (size_t)cur.pm * tstep + (size_t)cur.ko * 2; const char* cB = (const char*)g.Bt + (size_t)cur.pn * tstep + (size_t)cur.ko * 2;
    S.a_ready(cur);
    if constexpr (SP2) {
        PG8_STAGE(PG8_SB(0, 0), cB, voffB); PG8_STAGE(PG8_SB(0, 1), cB + hstepB, voffB); PG8_STAGE(PG8_SA(0, 0), cA, voffA); PG8_STAGE(PG8_SA(0, 1), cA + hstep, voffA);
        if (wr == 1) PG8_BAR;
        PG8_WAIT_V(2); PG8_BAR;
        PG8_STAGE(PG8_SB(1, 0), cB + kstep, voffB); PG8_STAGE(PG8_SA(1, 0), cA + kstep, voffA); PG8_STAGE(PG8_SB(1, 1), cB + hstepB + kstep, voffB);
        PG8_WAIT_V(6); PG8_BAR;
    } else {
        PG8_STAGE(PG8_SB(0, 0), cB, voffB); PG8_STAGE(PG8_SA(0, 0), cA, voffA); PG8_STAGE(PG8_SB(0, 1), cB + hstepB, voffB); PG8_STAGE(PG8_SA(0, 1), cA + hstep, voffA);
        if (wr == 1) PG8_BAR;
        PG8_WAIT_V(4); PG8_BAR;
        PG8_STAGE(PG8_SB(1, 0), cB + kstep, voffB); PG8_STAGE(PG8_SA(1, 0), cA + kstep, voffA); PG8_STAGE(PG8_SB(1, 1), cB + hstepB + kstep, voffB);
        PG8_WAIT_V(6); PG8_BAR;
    }
    for (;;) {
        const bool has_next = S.next(ui + 1, nxt);
        const char* nA = has_next ? (const char*)g.A + (size_t)nxt.pm * tstep + (size_t)nxt.ko * 2 : cA; const char* nB = has_next ? (const char*)g.Bt + (size_t)nxt.pn * tstep + (size_t)nxt.ko * 2 : cB;
        for (int t = 0; t < nt; t += 2) {
            const bool last = (t == nt - 2);
            const char* a1 = cA + (size_t)(t + 1) * kstep;
            const char* a2 = last ? nA : cA + (size_t)(t + 2) * kstep; const char* b2 = last ? nB : cB + (size_t)(t + 2) * kstep;
            const char* a3 = a2 + kstep; const char* b3 = b2 + kstep;
            if (last && has_next) S.a_ready(nxt);
            if (last) E.prefetch(pre, cur, tid);
            if constexpr (SP2) {
            PG8_LDB(B0, 0, 0); PG8_LDB(B1, 0, 1); PG8_SCHED; PG8_LDA(At, 0, 0); PG8_STAGE(PG8_SA(1, 1), a1 + hstep, voffA);
            PG8_WAIT_V(8); PG8_WAIT_L(0); PG8_BAR; PG8_MMA(0, 0, At, B0); PG8_MMA(0, 1, At, B1); PG8_BAR; PG8_SCHED;
            PG8_LDA(At, 0, 1); PG8_STAGE(PG8_SB(0, 0), b2, voffB); PG8_STAGE(PG8_SB(0, 1), b2 + hstepB, voffB); PG8_STAGE(PG8_SA(0, 0), a2, voffA);
            PG8_WAIT_V(8); PG8_WAIT_L(0); PG8_BAR; PG8_MMA(1, 0, At, B0); PG8_MMA(1, 1, At, B1); PG8_BAR; PG8_SCHED;
            PG8_LDB(B0, 1, 0); PG8_LDB(B1, 1, 1); PG8_SCHED; PG8_LDA(At, 1, 0); PG8_STAGE(PG8_SA(0, 1), a2 + hstep, voffA);
            PG8_WAIT_V(8); PG8_WAIT_L(0); PG8_BAR; PG8_MMA(0, 0, At, B0); PG8_MMA(0, 1, At, B1); PG8_BAR; PG8_SCHED;
            PG8_LDA(At, 1, 1); PG8_STAGE(PG8_SB(1, 0), b3, voffB); PG8_STAGE(PG8_SB(1, 1), b3 + hstepB, voffB); PG8_STAGE(PG8_SA(1, 0), a3, voffA);
            PG8_WAIT_V(8); PG8_WAIT_L(0); PG8_BAR; PG8_MMA(1, 0, At, B0); PG8_MMA(1, 1, At, B1); PG8_BAR; PG8_SCHED;
            } else {
            PG8_LDB(B0, 0, 0); PG8_SCHED; PG8_LDA(At, 0, 0); PG8_STAGE(PG8_SA(1, 1), a1 + hstep, voffA);
            PG8_WAIT_L(8); PG8_BAR; PG8_WAIT_L(0); PG8_MMA(0, 0, At, B0); PG8_BAR; PG8_SCHED;
            PG8_LDB(B1, 0, 1); PG8_STAGE(PG8_SB(0, 0), b2, voffB);
            PG8_BAR; PG8_WAIT_L(0); PG8_MMA(0, 1, At, B1); PG8_BAR;
            PG8_LDA(At, 0, 1); PG8_STAGE(PG8_SA(0, 0), a2, voffA);
            PG8_BAR; PG8_WAIT_L(0); PG8_MMA(1, 0, At, B0); PG8_BAR; PG8_SCHED;
            PG8_STAGE(PG8_SB(0, 1), b2 + hstepB, voffB);
            PG8_WAIT_V(6); PG8_BAR; PG8_MMA(1, 1, At, B1); PG8_BAR;
            PG8_LDB(B0, 1, 0); PG8_SCHED; PG8_LDA(At, 1, 0); PG8_STAGE(PG8_SA(0, 1), a2 + hstep, voffA);
            PG8_WAIT_L(8); PG8_BAR; PG8_WAIT_L(0); PG8_MMA(0, 0, At, B0); PG8_BAR; PG8_SCHED;
            PG8_LDB(B1, 1, 1); PG8_STAGE(PG8_SB(1, 0), b3, voffB);
            PG8_BAR; PG8_WAIT_L(0); PG8_MMA(0, 1, At, B1); PG8_BAR;
            PG8_LDA(At, 1, 1); PG8_STAGE(PG8_SA(1, 0), a3, voffA);
            PG8_BAR; PG8_WAIT_L(0); PG8_MMA(1, 0, At, B0); PG8_BAR; PG8_SCHED;
            PG8_STAGE(PG8_SB(1, 1), b3 + hstepB, voffB);
            PG8_WAIT_V(6); PG8_BAR; PG8_MMA(1, 1, At, B1); PG8_BAR;
            }
        }
        if constexpr (ALIGN_EPI) { if (wr == 0) PG8_BAR; }
        if constexpr (!Epi::AFTER_DRAIN) { E(acc, cur, wr, wc, fr, fq, pre); S.done(cur); }
        if (!has_next) break;
#pragma unroll
        for (int a = 0; a < 2; ++a)
#pragma unroll
            for (int b = 0; b < 2; ++b)
#pragma unroll
                for (int m = 0; m < 4; ++m)
#pragma unroll
                    for (int n = 0; n < 2; ++n) acc[a][b][m][n] = (f32x4){0.f, 0.f, 0.f, 0.f};
        cur = nxt; cA = nA; cB = nB; ++ui;
        if constexpr (ALIGN_EPI) { if (wr == 1) PG8_BAR; }
    }
    PG8_WAIT_V(0);
    if constexpr (!ALIGN_EPI) { if (wr == 0) PG8_BAR; }
    PG8_BAR;
    if constexpr (Epi::AFTER_DRAIN) { E.fused(acc, cur, wr, wc, fr, fq, lds, wid, lane); S.done(cur); }
#undef PG8_SA
#undef PG8_SB
#undef PG8_STAGE
#undef PG8_LDA
#undef PG8_LDB
#undef PG8_MMA
#undef PG8_WAIT_V
#undef PG8_WAIT_L
#undef PG8_BAR
#undef PG8_SCHED
}
}

namespace fa {
constexpr int D = 128;
constexpr float THR = 8.f;
constexpr float SCALE = 0.08838834764831845f;
#ifndef FA_PRIO
#define FA_PRIO 0
#endif
constexpr int NW = 8, QBLK = 32, KVBLK = 64, QB = NW * QBLK;
constexpr int SHM_V = KVBLK * D * 2, SHM_K = KVBLK * D * 2;
constexpr int LDS_BYTES = 2 * SHM_V + 2 * SHM_K + NW * 64 * 4;
constexpr int OST_PITCH = 272, LDS_BYTES_OST = LDS_BYTES + NW * QBLK * OST_PITCH;

typedef unsigned short bf16;
typedef short bf16x8 __attribute__((ext_vector_type(8)));
typedef short s16x4 __attribute__((ext_vector_type(4)));
typedef float f32x16 __attribute__((ext_vector_type(16)));
typedef float f32x4 __attribute__((ext_vector_type(4)));
typedef unsigned u32x4 __attribute__((ext_vector_type(4)));
template <class A, class Bt> struct same_t { static constexpr bool v = false; };
template <class A> struct same_t<A, A> { static constexpr bool v = true; };

#define KSWZ(row, colB) ((row) * 256 + ((colB) ^ (((row) & 7) << 4)))
#define SBAR() __builtin_amdgcn_sched_barrier(0)
__device__ __forceinline__ int v_st(int k, int c) { const int kk = (k & ~0xC) | ((k & 4) << 1) | ((k & 8) >> 1); return ((kk >> 3) * 4 + (c >> 5)) * 512 + ((kk & 7) * 32 + (c & 31)) * 2; }
__device__ __forceinline__ int v_rd_base(int lane) { return ((lane & 3) << 3) | (((lane >> 2) & 3) << 6) | (((lane >> 4) & 1) << 5) | (((lane >> 5) & 1) << 8); }
constexpr int v_rd_off(int d0, int ks, int half) { return d0 * 512 + ks * 4096 + half * 2048; }
__device__ __forceinline__ int crow(int r, int hi) { return (r & 3) + 8 * (r >> 2) + 4 * hi; }
__device__ __forceinline__ unsigned cvtpk(float lo, float hi) {
    unsigned r; asm volatile("v_cvt_pk_bf16_f32 %0, %1, %2" : "=v"(r) : "v"(lo), "v"(hi)); return r;
}
__device__ __forceinline__ bf16x8 pack8(f32x4 a, f32x4 b) {
    u32x4 w = {cvtpk(a[0], a[1]), cvtpk(a[2], a[3]), cvtpk(b[0], b[1]), cvtpk(b[2], b[3])};
    return *reinterpret_cast<bf16x8*>(&w);
}
template <class T> __device__ __forceinline__ bf16x8 load8(const T* p) {
    if constexpr (same_t<T, float>::v) { return pack8(*(const f32x4*)p, *(const f32x4*)(p + 4)); }
    else { return *reinterpret_cast<const bf16x8*>(p); }
}
__device__ __forceinline__ void mask_tile(f32x16& p0, f32x16& p1, int dq, unsigned W) {
    const float NEG = -__builtin_inff();
#pragma unroll
    for (int r = 0; r < 16; ++r) {
        const int c = (r & 3) + 8 * (r >> 2);
        if ((unsigned)(dq - c) >= W) p0[r] = NEG;
        if ((unsigned)(dq - c - 32) >= W) p1[r] = NEG;
    }
}
__device__ __forceinline__ void sel_tile(f32x16& p0, f32x16& p1, bool keep) {
    const float NEG = -__builtin_inff();
#pragma unroll
    for (int r = 0; r < 16; ++r) { p0[r] = keep ? p0[r] : NEG; p1[r] = keep ? p1[r] : NEG; }
}
__device__ __forceinline__ void partialSM(f32x16& p0, f32x16& p1, float& m_reg, float& mn, float& alpha) {
    float pmax = p0[0]; for (int r = 1; r < 16; ++r) pmax = fmaxf(pmax, p0[r]); for (int r = 0; r < 16; ++r) pmax = fmaxf(pmax, p1[r]);
    { auto rr = __builtin_amdgcn_permlane32_swap(__float_as_uint(pmax), __float_as_uint(pmax), false, false);
      pmax = fmaxf(__uint_as_float(rr[0]), __uint_as_float(rr[1])); }
    constexpr float C2 = 1.4426950408889634f * SCALE;
    if (__builtin_expect(__all((pmax - m_reg) * SCALE <= THR), 1)) { mn = m_reg; alpha = 1.f; }
    else { mn = fmaxf(m_reg, pmax); alpha = __builtin_amdgcn_exp2f((m_reg - mn) * C2); m_reg = mn; }
    const float mnL = -mn * C2;
    for (int r = 0; r < 16; ++r) p0[r] = fmaf(p0[r], C2, mnL); for (int r = 0; r < 16; ++r) p1[r] = fmaf(p1[r], C2, mnL);
    for (int r = 0; r < 16; ++r) p0[r] = __builtin_amdgcn_exp2f(p0[r]);
}
__device__ __forceinline__ void finishSM(f32x16& p0, f32x16& p1, float alpha, float& l_reg, bf16x8& pa0, bf16x8& pa1, bf16x8& pa2, bf16x8& pa3) {
    for (int r = 0; r < 16; ++r) p1[r] = __builtin_amdgcn_exp2f(p1[r]);
    float ps = 0; for (int r = 0; r < 16; ++r) ps += p0[r]; for (int r = 0; r < 16; ++r) ps += p1[r];
    { auto rr = __builtin_amdgcn_permlane32_swap(__float_as_uint(ps), __float_as_uint(ps), false, false);
      ps = __uint_as_float(rr[0]) + __uint_as_float(rr[1]); }
    l_reg = l_reg * alpha + ps;
#define PK4(P, B_, OUT) do { unsigned a0 = cvtpk(P[B_+0], P[B_+1]), a1 = cvtpk(P[B_+2], P[B_+3]);                          \
        unsigned b0 = cvtpk(P[B_+4], P[B_+5]), b1 = cvtpk(P[B_+6], P[B_+7]);                                             \
        auto r0 = __builtin_amdgcn_permlane32_swap(a0, b0, false, false); auto r1 = __builtin_amdgcn_permlane32_swap(a1, b1, false, false); \
        u32x4 w = {r0[0], r1[0], r0[1], r1[1]}; OUT = *reinterpret_cast<bf16x8*>(&w); } while (0)
    PK4(p0, 0, pa0); PK4(p0, 8, pa1); PK4(p1, 0, pa2); PK4(p1, 8, pa3);
#undef PK4
}
template <int KB, bool SK>
__device__ __forceinline__ void qkt(f32x16& p0, f32x16& p1, const char* K_lds, int r32, int hi, const bf16x8* qr, bool act) {
    if (SK && !act) { const float NEG = -__builtin_inff();
#pragma unroll
        for (int r = 0; r < 16; ++r) { p0[r] = NEG; p1[r] = NEG; } return; }
    p0 = f32x16{}; p1 = f32x16{};
    if (FA_PRIO) __builtin_amdgcn_s_setprio(1);
    const char* kb[4];
#pragma unroll
    for (int dd = 0; dd < 4; ++dd) kb[dd] = K_lds + KB * SHM_K + KSWZ(r32, (dd * 16 + hi * 8) * 2);
#pragma unroll
    for (int d0 = 0; d0 < 8; ++d0) { const char* a = kb[d0 & 3] + (d0 >> 2) * 128;
        bf16x8 b0 = *reinterpret_cast<const bf16x8*>(a);
        bf16x8 b1 = *reinterpret_cast<const bf16x8*>(a + 32 * 256);
        p0 = __builtin_amdgcn_mfma_f32_32x32x16_bf16(b0, qr[d0], p0, 0, 0, 0);
        p1 = __builtin_amdgcn_mfma_f32_32x32x16_bf16(b1, qr[d0], p1, 0, 0, 0); }
    if (FA_PRIO) __builtin_amdgcn_s_setprio(0);
}
template <int VB, bool SK>
__device__ __forceinline__ void pv_tile(f32x16* o, int vb0, bf16x8 pa0, bf16x8 pa1, bf16x8 pa2, bf16x8 pa3, bool act) {
    if (SK && !act) return;
#define TRRD(dst, off) asm volatile("ds_read_b64_tr_b16 %0, %1 offset:%2" : "=&v"(dst) : "v"(vb0), "i"(off) : "memory")
#define PV_D0(d0) do { s16x4 l0, l1, l2, l3, h0, h1, h2, h3; constexpr int b_ = VB * SHM_V + v_rd_off(d0, 0, 0);     \
        TRRD(l0, b_); TRRD(h0, b_ + 2048); TRRD(l1, b_ + 4096); TRRD(h1, b_ + 6144); TRRD(l2, b_ + 8192); TRRD(h2, b_ + 10240); TRRD(l3, b_ + 12288); TRRD(h3, b_ + 14336); \
        asm volatile("s_waitcnt lgkmcnt(0)" ::: "memory"); SBAR();                 \
        o[d0] = __builtin_amdgcn_mfma_f32_32x32x16_bf16(pa0, (bf16x8){l0[0], l0[1], l0[2], l0[3], h0[0], h0[1], h0[2], h0[3]}, o[d0], 0, 0, 0);   \
        o[d0] = __builtin_amdgcn_mfma_f32_32x32x16_bf16(pa1, (bf16x8){l1[0], l1[1], l1[2], l1[3], h1[0], h1[1], h1[2], h1[3]}, o[d0], 0, 0, 0);   \
        o[d0] = __builtin_amdgcn_mfma_f32_32x32x16_bf16(pa2, (bf16x8){l2[0], l2[1], l2[2], l2[3], h2[0], h2[1], h2[2], h2[3]}, o[d0], 0, 0, 0);   \
        o[d0] = __builtin_amdgcn_mfma_f32_32x32x16_bf16(pa3, (bf16x8){l3[0], l3[1], l3[2], l3[3], h3[0], h3[1], h3[2], h3[3]}, o[d0], 0, 0, 0); } while (0)
    if (FA_PRIO) __builtin_amdgcn_s_setprio(1);
    PV_D0(0); PV_D0(1); PV_D0(2); PV_D0(3);
    if (FA_PRIO) __builtin_amdgcn_s_setprio(0);
#undef PV_D0
#undef TRRD
}

template <class TIn, class TOut> struct BlockRef { const TIn* Q; const TIn* K; const TIn* V; TOut* O; const unsigned* sel; int P0; int W; int os; int pk; };
template <class TIn> struct Seam {
    bf16x8 qr[8];
    bf16x8 st_v0, st_v1, st_k0, st_k1; f32x4 sf0, sf1, sf2, sf3;
    f32x4 tq[16];
};
constexpr int PK_HS = 2048 * D;
__device__ __forceinline__ int q_woff(int pk, int wid) { return pk ? (wid >> 1) * PK_HS + (wid & 1) * (QBLK * D) : wid * (QBLK * D); }
__device__ __forceinline__ int swa_jlo(int P0, int W) { const int lowk = P0 - W + 1; return lowk > 0 ? lowk / KVBLK : 0; }
#define ROW(p, k0, rr) ((p) + (size_t)((k0) + (rr)) * D + sc)
#define VMW() asm volatile("s_waitcnt vmcnt(0)" ::: "memory")
#define VMWN(n) asm volatile("s_waitcnt vmcnt(%0)" :: "i"(n) : "memory")
#define SLOAD_H(Kp, Vp, k0) do { S.st_v0 = load8<TIn>(ROW(Vp, k0, sr)); S.st_v1 = load8<TIn>(ROW(Vp, k0, 32 + sr));              \
                         S.st_k0 = load8<TIn>(ROW(Kp, k0, sr)); S.st_k1 = load8<TIn>(ROW(Kp, k0, 32 + sr)); } while (0)
#define SWRITE_HK(bf) do { *(bf16x8*)(K_lds + (bf) * SHM_K + kws) = S.st_k0; *(bf16x8*)(K_lds + (bf) * SHM_K + kws + 32 * 256) = S.st_k1; } while (0)
#define SWRITE_HV(bf) do { *(bf16x8*)(V_lds + (bf) * SHM_V + vst0) = S.st_v0; *(bf16x8*)(V_lds + (bf) * SHM_V + vst1) = S.st_v1; } while (0)
#define SWRITE_H(bf) do { SWRITE_HV(bf); SWRITE_HK(bf); } while (0)
#define SLOAD_F(p, k0) do { S.sf0 = *(const f32x4*)ROW(p, k0, sr); S.sf1 = *(const f32x4*)(ROW(p, k0, sr) + 4);                \
                            S.sf2 = *(const f32x4*)ROW(p, k0, 32 + sr); S.sf3 = *(const f32x4*)(ROW(p, k0, 32 + sr) + 4); } while (0)
#define SWRITE_KF(bf) do { *(bf16x8*)(K_lds + (bf) * SHM_K + kws) = pack8(S.sf0, S.sf1); *(bf16x8*)(K_lds + (bf) * SHM_K + kws + 32 * 256) = pack8(S.sf2, S.sf3); } while (0)
#define SWRITE_VF(bf) do { *(bf16x8*)(V_lds + (bf) * SHM_V + vst0) = pack8(S.sf0, S.sf1); *(bf16x8*)(V_lds + (bf) * SHM_V + vst1) = pack8(S.sf2, S.sf3); } while (0)
template <class TIn, class TOut>
__device__ __forceinline__ void causal_swa_prime(const BlockRef<TIn, TOut>& cur, char* lds, Seam<TIn>& S, const int wv) {
    const int W = cur.W;
    constexpr bool F32 = same_t<TIn, float>::v;
    const int tid = opaque_tid(wv), wid = __builtin_amdgcn_readfirstlane(tid >> 6), lane = tid & 63, r32 = lane & 31, hi = lane >> 5;
    const int sr = tid >> 4, sc = (tid & 15) * 8, kws = KSWZ(sr, sc * 2); char* K_lds = lds + 2 * SHM_V;
    const int kb0 = swa_jlo(cur.P0, W) * KVBLK;
    for (int d0 = 0; d0 < 8; ++d0) S.qr[d0] = load8<TIn>(cur.Q + q_woff(cur.pk, wid) + (size_t)r32 * D + d0 * 16 + hi * 8);
    if constexpr (F32) { SLOAD_F((const float*)cur.K, kb0); VMW(); SWRITE_KF(0); SBAR(); SLOAD_F((const float*)cur.V, kb0); }
    else { SLOAD_H(cur.K, cur.V, kb0); VMW(); SWRITE_HK(0); }
    __syncthreads();
}
template <class TOut> struct OutRef { TOut* O; int os; int pk; const float* gates; long dC, dS; };
template <class TIn, class TOut, class NX, class OX>
__device__ __forceinline__ void causal_swa_block(const BlockRef<TIn, TOut>& cur, const NX& nxf, const OX& oxf, int skv, char* lds, Seam<TIn>& S, const int wv) {
    const int W = cur.W;
    constexpr bool F32 = same_t<TIn, float>::v;
    const int tid = opaque_tid(wv), wid = __builtin_amdgcn_readfirstlane(tid >> 6), lane = tid & 63, r32 = lane & 31, hi = lane >> 5;
    const int j_lo = swa_jlo(cur.P0, W);
    int j_hi = (cur.P0 + (cur.pk ? 2 * QBLK : QB) - 1) / KVBLK + 1; if (j_hi > skv / KVBLK) j_hi = skv / KVBLK;
    const int NT = j_hi - j_lo;
    const int qlo = cur.P0 + (cur.pk ? (wid & 1) : wid) * QBLK, qm = qlo + r32 - 4 * hi;
    char* V_lds = lds; char* K_lds = lds + 2 * SHM_V;
    float* ws = (float*)(lds + 2 * SHM_V + 2 * SHM_K) + wid * 64; float* li_l = ws, * al_l = ws + 32;
    float m_reg = -1e30f, l_reg = 0; f32x16 o[4] = {};
    const bool has_sel = cur.sel != nullptr;
    const unsigned selw = has_sel ? cur.sel[qlo + r32] : 0xffffffffu;
    const int sr = tid >> 4, sc = (tid & 15) * 8, vst0 = v_st(sr, sc), vst1 = v_st(32 + sr, sc), kws = KSWZ(sr, sc * 2);
    const int vb0 = (int)(uintptr_t)V_lds + v_rd_base(lane);
    const TIn* Kh = cur.K; const TIn* Vh = cur.V;
#define RESC(a) do { if (__any((a) < 1.f)) { if (hi == 0) al_l[r32] = (a); asm volatile("s_waitcnt lgkmcnt(0)" ::: "memory");              \
                     for (int d_ = 0; d_ < 4; ++d_) for (int r = 0; r < 16; ++r) o[d_][r] *= al_l[crow(r, hi)]; } } while (0)
#define KBASE(t) ((j_lo + (t)) * KVBLK)
#define ACT(t) (KBASE(t) <= qlo + QBLK - 1 && KBASE(t) + KVBLK - 1 >= qlo - W + 1)
#define MASKT(P0_, P1_, t) do { const int kb_ = KBASE(t); if ((!SK || ACT(t)) && (kb_ + KVBLK - 1 > qlo || kb_ <= qlo + QBLK - 1 - W)) mask_tile(P0_, P1_, qm - kb_, (unsigned)W); \
        if (has_sel) sel_tile(P0_, P1_, ((selw >> (j_lo + (t))) & 1u) != 0u); } while (0)
    constexpr int NQL = F32 ? 16 : 8;
    constexpr bool SK = false;
#define SEAM_K0() do { VMWN(NQL); if constexpr (F32) { SWRITE_KF(0); SBAR(); SLOAD_F((const float*)nxt.V, kbn); } else { SWRITE_HK(0); } SBAR(); } while (0)
    f32x16 pA0, pA1, pB0, pB1; float mnA, mnB, alA, alB; bf16x8 pa0, pa1, pa2, pa3;
    if constexpr (F32) { VMW(); SWRITE_VF(0); SBAR(); } else { SWRITE_HV(0); SBAR(); }
    if (NT > 1) { if constexpr (F32) SLOAD_F((const float*)Kh, KBASE(1)); else SLOAD_H(Kh, Vh, KBASE(1)); }
    SBAR(); qkt<0, SK>(pA0, pA1, K_lds, r32, hi, S.qr, ACT(0));
    if constexpr (F32) { if (NT > 1) { VMW(); SWRITE_KF(1); SBAR(); SLOAD_F((const float*)Vh, KBASE(1)); } }
    MASKT(pA0, pA1, 0); partialSM(pA0, pA1, m_reg, mnA, alA);
    if (NT > 1) { VMW(); if constexpr (F32) { SWRITE_VF(1); SBAR(); if (NT > 2) SLOAD_F((const float*)Kh, KBASE(2)); } else SWRITE_H(1); }
    __syncthreads();
#define HALF_STEP(PX0, PX1, mnX, alX, PY0, PY1, alY, t, KB, VB, SB) do {                                                      \
        SBAR(); qkt<KB, SK>(PX0, PX1, K_lds, r32, hi, S.qr, ACT(t));                                             \
        finishSM(PY0, PY1, alY, l_reg, pa0, pa1, pa2, pa3); SBAR();                                                           \
        if ((t) + 1 < NT) { if constexpr (F32) { VMW(); SWRITE_KF(SB); SBAR(); SLOAD_F((const float*)Vh, KBASE((t) + 1)); }  \
                            else { SLOAD_H(Kh, Vh, KBASE((t) + 1)); } SBAR(); }                                               \
        pv_tile<VB, SK>(o, vb0, pa0, pa1, pa2, pa3, ACT((t) - 1)); MASKT(PX0, PX1, (t)); partialSM(PX0, PX1, m_reg, mnX, alX);                                        \
        __syncthreads();                                                                                                      \
        if ((t) + 1 < NT) { VMW(); if constexpr (F32) { SWRITE_VF(SB); SBAR(); if ((t) + 2 < NT) SLOAD_F((const float*)Kh, KBASE((t) + 2)); } \
                            else { SWRITE_H(SB); } }                                                                          \
        RESC(alX); __syncthreads(); } while (0)
    for (int t = 1; t + 1 < NT; t += 2) {
        HALF_STEP(pB0, pB1, mnB, alB, pA0, pA1, alA, t, 1, 0, 0);
        HALF_STEP(pA0, pA1, mnA, alA, pB0, pB1, alB, t + 1, 0, 1, 1);
    }
    const bool even = (NT & 1) == 0;
    if (even) { SBAR(); qkt<1, SK>(pB0, pB1, K_lds, r32, hi, S.qr, ACT(NT - 1)); SBAR(); }
    const BlockRef<TIn, TOut> nxt = nxf(); const int kbn = swa_jlo(nxt.P0, nxt.W) * KVBLK;
#define QROW(e) (nxt.Q + q_woff(nxt.pk, wid) + (size_t)r32 * D + ((e) >> 1) * 16 + hi * 8 + ((e) & 1) * 4)
    if constexpr (F32) { SLOAD_F((const float*)nxt.K, kbn); SBAR();
#pragma unroll
        for (int e = 0; e < 8; ++e) S.tq[e] = *(const f32x4*)QROW(e); }
    else { SLOAD_H(nxt.K, nxt.V, kbn); SBAR();
#pragma unroll
        for (int d0 = 0; d0 < 8; ++d0) S.qr[d0] = load8<TIn>(nxt.Q + q_woff(nxt.pk, wid) + (size_t)r32 * D + d0 * 16 + hi * 8); }
    SBAR();
    finishSM(pA0, pA1, alA, l_reg, pa0, pa1, pa2, pa3); SBAR();
    if constexpr (F32) {
#pragma unroll
        for (int e = 8; e < 16; ++e) S.tq[e] = *(const f32x4*)QROW(e); SBAR(); }
#undef QROW
    pv_tile<0, SK>(o, vb0, pa0, pa1, pa2, pa3, ACT(even ? NT - 2 : NT - 1));
    if (even) { MASKT(pB0, pB1, NT - 1); partialSM(pB0, pB1, m_reg, mnB, alB); __syncthreads(); RESC(alB);
        finishSM(pB0, pB1, alB, l_reg, pa0, pa1, pa2, pa3); SBAR(); pv_tile<1, SK>(o, vb0, pa0, pa1, pa2, pa3, ACT(NT - 1)); }
    SBAR(); SEAM_K0();
    if (hi == 0) li_l[r32] = l_reg; asm volatile("s_waitcnt lgkmcnt(0)" ::: "memory");
    float rli[16];
#pragma unroll
    for (int r = 0; r < 16; ++r) rli[r] = __builtin_amdgcn_rcpf(li_l[crow(r, hi)]);
    const OutRef<TOut> orf = oxf(); const int os = orf.os; TOut* Ow = orf.O + (orf.pk ? (size_t)(wid >> 1) * D + (size_t)((wid & 1) * QBLK) * os : (size_t)(wid * QBLK) * os);
    char* ost = lds + LDS_BYTES + wid * (QBLK * OST_PITCH);
#pragma unroll
    for (int r = 0; r < 16; ++r) { const int orow = crow(r, hi);
#pragma unroll
        for (int d0 = 0; d0 < 4; ++d0) { const float v = o[d0][r] * rli[r];
            if constexpr (same_t<TOut, float>::v) { Ow[(size_t)orow * os + d0 * 32 + r32] = v; }
            else { *(unsigned short*)(ost + orow * OST_PITCH + (d0 * 32 + r32) * 2) = (unsigned short)cvtpk(v, v); } } }
    if constexpr (!same_t<TOut, float>::v) {
        asm volatile("s_waitcnt lgkmcnt(0)" ::: "memory");
#pragma unroll
        for (int it = 0; it < 8; ++it) { const int row = it * 4 + (lane >> 4), cb = (lane & 15) * 16;
            const u32x4 w = *reinterpret_cast<const u32x4*>(ost + row * OST_PITCH + cb);
            char* dst = reinterpret_cast<char*>(Ow + (size_t)row * os) + cb;
            if (orf.gates != nullptr) {
                const f32x4 g4 = *reinterpret_cast<const f32x4*>(orf.gates + ((size_t)((wid & 1) * QBLK + row) * 16 + (wid >> 1)) * 4);
                const u32x4 c4 = *reinterpret_cast<const u32x4*>(dst + orf.dC), s4 = *reinterpret_cast<const u32x4*>(dst + orf.dS);
                u32x4 o4;
#pragma unroll
                for (int q = 0; q < 4; ++q) {
                    const float lo = g4[0] * __uint_as_float(c4[q] << 16) + g4[1] * __uint_as_float(s4[q] << 16) + g4[2] * __uint_as_float(w[q] << 16);
                    const float hv = g4[0] * __uint_as_float(c4[q] & 0xffff0000u) + g4[1] * __uint_as_float(s4[q] & 0xffff0000u) + g4[2] * __uint_as_float(w[q] & 0xffff0000u);
                    o4[q] = cvtpk(lo, hv); }
                *reinterpret_cast<u32x4*>(dst) = o4;
            } else *reinterpret_cast<u32x4*>(dst) = w; } }
    if constexpr (F32) {
#pragma unroll
        for (int d0 = 0; d0 < 8; ++d0) S.qr[d0] = pack8(S.tq[2 * d0], S.tq[2 * d0 + 1]); }
    __syncthreads();
#undef RESC
#undef KBASE
#undef ACT
#undef MASKT
#undef SEAM_K0
#undef HALF_STEP
}
#undef ROW
#undef VMW
#undef VMWN
#undef SLOAD_H
#undef SWRITE_HK
#undef SWRITE_HV
#undef SWRITE_H
#undef SLOAD_F
#undef SWRITE_KF
#undef SWRITE_VF

}

#define GAS __attribute__((address_space(1)))
#define LAS __attribute__((address_space(3)))
typedef unsigned short bf16;
typedef unsigned v4u __attribute__((ext_vector_type(4)));
typedef float f32x4 __attribute__((ext_vector_type(4)));
typedef short bf16x8 __attribute__((ext_vector_type(8)));
typedef GAS unsigned gu32;
typedef GAS unsigned long long gu64;
#define RLX_AGENT __ATOMIC_RELAXED, __HIP_MEMORY_SCOPE_AGENT
#define LDS_WAIT() asm volatile("s_waitcnt lgkmcnt(0)" ::: "memory")
#define VM_WAIT() asm volatile("s_waitcnt vmcnt(0)" ::: "memory")
__device__ __forceinline__ unsigned long long rt() { return __builtin_amdgcn_s_memrealtime(); }
__device__ __forceinline__ unsigned f2bf(float f) { unsigned u = __builtin_bit_cast(unsigned, f); return (u + 0x7fffu + ((u >> 16) & 1u)) >> 16; }
__device__ __forceinline__ unsigned pk2(float lo, float hi) { return f2bf(lo) | (f2bf(hi) << 16); }

#define XB_TMO      128
#define XB_XCNT(j)  (256  + 64 * (j))
#define XB_XSUB(j)  (1280 + 64 * (j))
#define XB_XGEN(j)  (2304 + 64 * (j))
#define XB_TOP      3328
#define XB_TOPGEN   3392
#define XCD_BAR_WORDS 3456
#define XB_SPIN_CAP (1u << 18)

__device__ __forceinline__ unsigned xb_ld(unsigned* p)              { return __hip_atomic_load(p, __ATOMIC_RELAXED, __HIP_MEMORY_SCOPE_AGENT); }
__device__ __forceinline__ unsigned xb_add(unsigned* p, unsigned v) { return __hip_atomic_fetch_add(p, v, __ATOMIC_RELAXED, __HIP_MEMORY_SCOPE_AGENT); }
__device__ __forceinline__ unsigned xb_xcc_id() { return (unsigned)__builtin_amdgcn_s_getreg((3 << 11) | 20) & 0xFu; }
#define XB_SPIN(cond, bar) do { unsigned _sp = 0; while (cond) { __builtin_amdgcn_s_sleep(1); \
    if ((++_sp & 255u) == 0u) { if (xb_ld(&(bar)[XB_TMO])) break; if (_sp > XB_SPIN_CAP) { atomicAdd(&(bar)[XB_TMO], 1u); break; } } } } while (0)

struct XcdBarrier {
    unsigned* bar; unsigned x; unsigned G;
    volatile LAS unsigned* st;
};

__device__ __forceinline__ XcdBarrier xcd_barrier_post(unsigned* bar, volatile LAS unsigned* st, unsigned G) {
    XcdBarrier b; b.bar = bar; b.x = xb_xcc_id(); b.st = st; b.G = G;
    if (threadIdx.x == 0) (void)xb_add(&bar[XB_XCNT(b.x)], 1u);
    return b;
}
__device__ __forceinline__ void xcd_barrier_complete(unsigned* bar, unsigned x, unsigned G, unsigned& nloc, unsigned& nx) {
    unsigned sum, cnt, mine, sp = 0u;
    for (;;) {
        sum = 0u; cnt = 0u; mine = 0u;
#pragma unroll
        for (unsigned j = 0; j < 16; ++j) { const unsigned c = xb_ld(&bar[XB_XCNT(j)]); sum += c; cnt += (c > 0u) ? 1u : 0u; mine = (j == x) ? c : mine; }
        if (sum == G) break;
        __builtin_amdgcn_s_sleep(1);
        if ((++sp & 255u) == 0u) { if (xb_ld(&bar[XB_TMO])) break; if (sp > XB_SPIN_CAP) { atomicAdd(&bar[XB_TMO], 1u); break; } }
    }
    nloc = mine > 0u ? mine : 1u; nx = cnt > 0u ? cnt : 1u;
}

__device__ __forceinline__ void xcd_barrier(const XcdBarrier& b) {
    asm volatile("s_waitcnt vmcnt(0)" ::: "memory");
    __syncthreads();
    if (threadIdx.x == 0) {
        unsigned* bar = b.bar;
        __builtin_amdgcn_s_waitcnt(0);
        unsigned nloc = b.st[0], nx = b.st[1];
        if (nloc == 0u) { xcd_barrier_complete(bar, b.x, b.G, nloc, nx); b.st[0] = nloc; b.st[1] = nx; }
        const unsigned old = xb_add(&bar[XB_XSUB(b.x)], 1u);
        const unsigned gen = old / nloc;
        if (old + 1u == (gen + 1u) * nloc) {
            __builtin_amdgcn_fence(__ATOMIC_RELEASE, "agent");
            asm volatile("s_waitcnt vmcnt(0)" ::: "memory");
            const unsigned og = xb_add(&bar[XB_TOP], 1u);
            const unsigned tg = og / nx;
            if (og + 1u == (tg + 1u) * nx) xb_add(&bar[XB_TOPGEN], 1u);
            else XB_SPIN(xb_ld(&bar[XB_TOPGEN]) == tg, bar);
            __builtin_amdgcn_fence(__ATOMIC_ACQUIRE, "agent");
            xb_add(&bar[XB_XGEN(b.x)], 1u);
            asm volatile("s_waitcnt vmcnt(0)" ::: "memory");
        } else {
            XB_SPIN(xb_ld(&bar[XB_XGEN(b.x)]) == gen, bar);
            __builtin_amdgcn_fence(__ATOMIC_ACQUIRE, "agent");
            asm volatile("s_waitcnt vmcnt(0)" ::: "memory");
        }
    }
    __syncthreads();
}

#define DEVI __device__ __forceinline__
typedef float f32x16 __attribute__((ext_vector_type(16)));
typedef unsigned u32x2 __attribute__((ext_vector_type(2)));
typedef float f32x2 __attribute__((ext_vector_type(2)));

struct Ctx { LAS unsigned char* lds; char* ldsg; int tid, lane, wave, bid, vcu, G, gw, NGW; int m0, MS, b0, NBS; };
DEVI const float* inp(const Ctx& F, int k) { const LAS unsigned* p = (const LAS unsigned*)(F.lds + PTR_OFF) + 2 * k; const unsigned lo = __builtin_amdgcn_readfirstlane(p[0]), hi = __builtin_amdgcn_readfirstlane(p[1]);
    return (const float*)(((unsigned long long)hi << 32) | lo); }

__device__ const float ROPE_INV[64] = {
1.000000000e+00f, 8.659643531e-01f, 7.498942018e-01f, 6.493816376e-01f, 5.623413324e-01f, 4.869675338e-01f, 4.216965139e-01f, 3.651741147e-01f, 3.162277639e-01f, 2.738419771e-01f, 2.371373773e-01f, 2.053525001e-01f, 1.778279394e-01f, 1.539926529e-01f, 1.333521456e-01f, 1.154781953e-01f,
1.000000015e-01f, 8.659642935e-02f, 7.498942316e-02f, 6.493816525e-02f, 5.623413250e-02f, 4.869675264e-02f, 4.216964915e-02f, 3.651741147e-02f, 3.162277490e-02f, 2.738419548e-02f, 2.371373773e-02f, 2.053525113e-02f, 1.778279431e-02f, 1.539926510e-02f, 1.333521400e-02f, 1.154781971e-02f,
9.999999776e-03f, 8.659643121e-03f, 7.498942316e-03f, 6.493816152e-03f, 5.623413250e-03f, 4.869675264e-03f, 4.216964822e-03f, 3.651741194e-03f, 3.162277630e-03f, 2.738419687e-03f, 2.371373819e-03f, 2.053525066e-03f, 1.778279431e-03f, 1.539926510e-03f, 1.333521446e-03f, 1.154782018e-03f,
1.000000047e-03f, 8.659643354e-04f, 7.498941850e-04f, 6.493816036e-04f, 5.623413017e-04f, 4.869675322e-04f, 4.216965172e-04f, 3.651741135e-04f, 3.162277571e-04f, 2.738419571e-04f, 2.371373703e-04f, 2.053525095e-04f, 1.778279402e-04f, 1.539926598e-04f, 1.333521504e-04f, 1.154782003e-04f};

DEVI float bflo(unsigned w) { return __uint_as_float(w << 16); }
DEVI float bfhi(unsigned w) { return __uint_as_float(w & 0xffff0000u); }
DEVI float wave_sum(float v) {
#pragma unroll
    for (int o = 1; o < 64; o <<= 1) v += __shfl_xor(v, o);
    return v;
}
DEVI f32x16 mfma32(bf16x8 a, bf16x8 b, f32x16 c) { return __builtin_amdgcn_mfma_f32_32x32x16_bf16(a, b, c, 0, 0, 0); }
DEVI int crow(int r, int hi) { return (r & 3) + 8 * (r >> 2) + 4 * hi; }

DEVI int wrow_perm(int n, int perm) {
    const bool p = perm == 2 ? n < 4096 : (perm == 1 && (n < 2048 || (n >= 3072 && n < 3584) || (n >= 4096 && n < 4608)));
    if (!p) return n; const int d = n & 127; return (n & ~127) + 8 * ((d & 63) >> 2) + 4 * (d >> 6) + (d & 3); }
DEVI void tr_item(const float* W, int K, int N, bf16* WT, LAS float* scr, int kb, int nb, int lane, int perm) {
    const int k0 = 64 * kb, n0 = 64 * nb, kr = lane >> 4, nq = lane & 15; const bool ok = n0 + 4 * nq < N;
    const GAS float* src = (const GAS float*)W + (size_t)k0 * N + n0;
    const int loff = kr * N + 4 * nq;
    f32x4 v[16];
#pragma unroll
    for (int i = 0; i < 16; ++i) v[i] = ok ? *(const GAS f32x4*)(src + (size_t)(4 * i) * N + loff) : (f32x4){0.f, 0.f, 0.f, 0.f};
#pragma unroll
    for (int i = 0; i < 16; ++i) { LAS float* d = scr + (4 * i + kr) * 65 + 4 * nq; d[0] = v[i].x; d[1] = v[i].y; d[2] = v[i].z; d[3] = v[i].w; }
    LDS_WAIT(); asm volatile("" ::: "memory");
    const int c = lane & 7, nr = lane >> 3;
#pragma unroll
    for (int j = 0; j < 8; ++j) { const int n = nr + 8 * j; const LAS float* s = scr + (8 * c) * 65 + n;
        v4u o; o.x = pk2(s[0 * 65], s[1 * 65]); o.y = pk2(s[2 * 65], s[3 * 65]); o.z = pk2(s[4 * 65], s[5 * 65]); o.w = pk2(s[6 * 65], s[7 * 65]);
        if (perm == 3) { const int f = n0 + n, k = k0 + 8 * c;
            *(GAS v4u*)(WT + ((((size_t)(f >> 5) * 8 + (k >> 9)) * 32 + ((k & 511) >> 4)) * 64 + (((k >> 3) & 1) * 32 + (f & 31))) * 8) = o; }
        else *(GAS v4u*)(WT + (size_t)wrow_perm(n0 + n, perm) * K + k0 + 8 * c) = o; }
    LDS_WAIT(); asm volatile("" ::: "memory");
}

DEVI void p0_weights(const Ctx& F, unsigned char* ws, int defer);
DEVI void p0_prologue(const Ctx& F, unsigned char* ws, int defer) {
    LAS float* scL = (LAS float*)(F.lds);
    { const float* cc = inp(F, 1);
      for (int idx = F.tid; idx < NB * DM; idx += NWAVES * 64) { const int b = idx >> 11, k = idx & 2047; const float v = cc[idx]; scL[k * 8 + b] = v / (1.f + expf(-v)); } }
    __syncthreads();
    { const GAS float* adaw = (const GAS float*)inp(F, 3);
    for (int id = F.gw; id < 1536; id += F.NGW) {
        const int l = id / 384, rem = id % 384, ks = rem / 48, cg = rem % 48, colu = cg * 256, col0 = colu + 4 * F.lane, k0 = ks * 256, loff = 4 * F.lane;
        const GAS float* wp = adaw + ((size_t)l * DM + k0) * MODW + colu;
        f32x4 a0 = {0, 0, 0, 0}, a1 = a0, a2 = a0, a3 = a0, a4 = a0, a5 = a0, a6 = a0, a7 = a0;
        for (int kk = 0; kk < 256; kk += 8) {
            f32x4 w[8];
#pragma unroll
            for (int u = 0; u < 8; ++u) w[u] = *(const GAS f32x4*)(wp + (size_t)(kk + u) * MODW + loff);
#pragma unroll
            for (int u = 0; u < 8; ++u) { const f32x4 s0 = *(const LAS f32x4*)(scL + (k0 + kk + u) * 8), s1 = *(const LAS f32x4*)(scL + (k0 + kk + u) * 8 + 4);
                a0 += s0.x * w[u]; a1 += s0.y * w[u]; a2 += s0.z * w[u]; a3 += s0.w * w[u]; a4 += s1.x * w[u]; a5 += s1.y * w[u]; a6 += s1.z * w[u]; a7 += s1.w * w[u]; }
        }
        float* pp = (float*)(ws + WS_MODP) + (((size_t)ks * 4 + l) * 8) * MODW + col0;
        *(GAS f32x4*)(pp + 0 * MODW) = a0; *(GAS f32x4*)(pp + 1 * MODW) = a1; *(GAS f32x4*)(pp + 2 * MODW) = a2; *(GAS f32x4*)(pp + 3 * MODW) = a3;
        *(GAS f32x4*)(pp + 4 * MODW) = a4; *(GAS f32x4*)(pp + 5 * MODW) = a5; *(GAS f32x4*)(pp + 6 * MODW) = a6; *(GAS f32x4*)(pp + 7 * MODW) = a7;
    } }
    { const int* pos = (const int*)inp(F, 2); float* rope = (float*)(ws + WS_ROPE); const float inv = ROPE_INV[F.lane];
      for (int m = F.gw; m < M; m += F.NGW) { const float ang = (float)pos[m] * inv; const double rev = (double)ang * 0.15915494309189535; const float fr = (float)(rev - rint(rev));
          ((GAS unsigned*)rope)[(size_t)m * 64 + F.lane] = pg8::cvt_pk_f16(__builtin_amdgcn_cosf(fr), __builtin_amdgcn_sinf(fr)); } }
    __syncthreads();
    p0_weights(F, ws, defer);
}
DEVI void p0_weights(const Ctx& F, unsigned char* ws, int defer) {
    LAS float* scr = (LAS float*)(F.lds + F.wave * 16640);
    constexpr int I_W1 = 32 * 128, I_W2 = 128 * 32, I_NI = 32 * 84, I_NO = 32 * 32, I_DI = 32 * 96, I_DO = 32 * 32, I_C1 = 64 * 4, I_C2 = 4 * 2;
    constexpr int NITEMS = 4 * I_W1 + 4 * I_W2 + 2 * (I_NI + I_NO + I_DI + I_DO) + 4 * I_C1 + 4 * I_C2;
    for (int it = F.gw; it < NITEMS; it += F.NGW) {
        int r = it; const float* W; bf16* WT; int K, N, nblk, perm = 0;
        { const bool l3 = r >= 4 * I_W1 + 2 * I_W2 && r < 4 * I_W1 + 4 * I_W2; if ((defer == 1 && l3) || (defer == 2 && !l3)) continue; }
        if (r < 4 * I_W1) { const int l = r / I_W1; r -= l * I_W1; W = inp(F, 7) + (size_t)l * DM * DFF; WT = (bf16*)(ws + WS_W1T) + (size_t)l * DFF * DM; K = DM; N = DFF; nblk = 128; }
        else if ((r -= 4 * I_W1) < 4 * I_W2) { const int l = r / I_W2; r -= l * I_W2; W = inp(F, 8) + (size_t)l * DFF * DM; WT = (bf16*)(ws + WS_W2T) + (size_t)l * DM * DFF; K = DFF; N = DM; nblk = 32; }
        else if ((r -= 4 * I_W2) < 2 * I_NI) { const int j = r / I_NI; r -= j * I_NI; W = inp(F, 9) + (size_t)j * DM * NSA_IN; WT = (bf16*)(ws + WS_NWIN) + (size_t)j * NSA_INP * DM; K = DM; N = NSA_IN; nblk = 84; perm = 1; }
        else if ((r -= 2 * I_NI) < 2 * I_NO) { const int j = r / I_NO; r -= j * I_NO; W = inp(F, 10) + (size_t)j * DM * DM; WT = (bf16*)(ws + WS_NWOUT) + (size_t)j * DM * DM; K = DM; N = DM; nblk = 32; }
        else if ((r -= 2 * I_NO) < 2 * I_DI) { const int j = r / I_DI; r -= j * I_DI; W = inp(F, 16) + (size_t)j * DM * DIFF_IN; WT = (bf16*)(ws + WS_DWIN) + (size_t)j * DIFF_IN * DM; K = DM; N = DIFF_IN; nblk = 96; perm = 2; }
        else if ((r -= 2 * I_DI) < 2 * I_DO) { const int j = r / I_DO; r -= j * I_DO; W = inp(F, 17) + (size_t)j * DM * DM; WT = (bf16*)(ws + WS_DWOUT) + (size_t)j * DM * DM; K = DM; N = DM; nblk = 32; }
        else if ((r -= 2 * I_DO) < 4 * I_C1) { const int q = r / I_C1; r -= q * I_C1; W = inp(F, 14) + (size_t)q * 4096 * 256; WT = (bf16*)(ws + WS_CW1) + (size_t)q * 256 * 4096; K = 4096; N = 256; nblk = 4; perm = 3; }
        else { r -= 4 * I_C1; const int q = r / I_C2; r -= q * I_C2; W = inp(F, 15) + (size_t)q * 256 * 128; WT = (bf16*)(ws + WS_CW2) + (size_t)q * 128 * 256; K = 256; N = 128; nblk = 2; }
        tr_item(W, K, N, WT, scr, r / nblk, r % nblk, F.lane, perm);
    }
}

DEVI void p1_mod(const Ctx& F, unsigned char* ws) {
    const float* part = (const float*)(ws + WS_MODP); float* mod = (float*)(ws + WS_MOD); const float* ab = inp(F, 4); float* gsb = (float*)(ws + WS_GS); const float* ag = inp(F, 5); const float* mg = inp(F, 6);
    const int gt = (F.vcu * NWAVES + F.wave) * 64 + F.lane, GT = F.NGW * 64;
    for (int idx = gt; idx < 4 * NB * MODW; idx += GT) { const int l = idx / (NB * MODW), rem = idx - l * (NB * MODW), e = rem % MODW;
        float s = ab[l * MODW + e];
#pragma unroll
        for (int ks = 0; ks < 8; ++ks) s += part[((size_t)ks * 4 + l) * (NB * MODW) + rem];
        mod[idx] = s;
        const int seg = e / DM, c = e - seg * DM, b = rem / MODW;
        if (seg == 1) gsb[((size_t)(2 * l) * NB + b) * DM + c] = ag[l * DM + c] * (1.f + s);
        if (seg == 4) gsb[((size_t)(2 * l + 1) * NB + b) * DM + c] = mg[l * DM + c] * (1.f + s); }
}

DEVI void p2_first(const Ctx& F, unsigned char* ws) {
    { const float* x = inp(F, 0); const float* gs = (const float*)(ws + WS_GS); bf16* out = (bf16*)(ws + WS_H); float* ssq = (float*)(ws + WS_SSQ);
      const int wpb = F.NGW >> 3, b = F.gw / wpb, wl = F.gw - b * wpb;
      if (b < NB) {
        f32x4 g[4][2];
#pragma unroll
        for (int j = 0; j < 4; ++j) { g[j][0] = *(const GAS f32x4*)(gs + (size_t)b * DM + 8 * F.lane + 512 * j); g[j][1] = *(const GAS f32x4*)(gs + (size_t)b * DM + 8 * F.lane + 512 * j + 4); }
        for (int t = wl; t < T; t += wpb) { const int m = b * T + t;
            const GAS float* xr = (const GAS float*)x + (size_t)m * DM + 8 * F.lane;
            f32x4 v[4][2]; float ss = 0.f;
#pragma unroll
            for (int j = 0; j < 4; ++j) { v[j][0] = *(const GAS f32x4*)(xr + 512 * j); v[j][1] = *(const GAS f32x4*)(xr + 512 * j + 4);
                ss += ((v[j][0].x * v[j][0].x + v[j][0].y * v[j][0].y) + (v[j][0].z * v[j][0].z + v[j][0].w * v[j][0].w)) + ((v[j][1].x * v[j][1].x + v[j][1].y * v[j][1].y) + (v[j][1].z * v[j][1].z + v[j][1].w * v[j][1].w)); }
            ss = wave_sum(ss);
            if (F.lane < 8) ssq[(size_t)m * 8 + F.lane] = F.lane == 0 ? ss : 0.f;
#pragma unroll
            for (int j = 0; j < 4; ++j) { const f32x4 y0 = v[j][0] * g[j][0], y1 = v[j][1] * g[j][1];
                v4u w; w.x = pk2(y0.x, y0.y); w.y = pk2(y0.z, y0.w); w.z = pk2(y1.x, y1.y); w.w = pk2(y1.z, y1.w);
                *(GAS v4u*)(out + (size_t)m * DM + 8 * F.lane + 512 * j) = w; } } } }
    LAS bf16* shL = (LAS bf16*)(F.lds);
    const int r = F.lane & 31, hi = F.lane >> 5;
    {
        const int site = F.bid & 7, wi = (F.bid >> 3) * NWAVES + F.wave, nwi = (F.G >> 3) * NWAVES;
        const int l = site >> 1, which = site & 1, j = l >> 1;
        const float* sh = (const float*)(ws + WS_MOD) + (size_t)l * NB * MODW + (which ? 3 * DM : 0);
        const bf16* Wt; int N;
        if (which) { Wt = (const bf16*)(ws + WS_W1T) + (size_t)l * DFF * DM; N = DFF; }
        else if ((l & 1) == 0) { Wt = (const bf16*)(ws + WS_NWIN) + (size_t)j * NSA_INP * DM; N = NSA_INP; }
        else { Wt = (const bf16*)(ws + WS_DWIN) + (size_t)j * DIFF_IN * DM; N = DIFF_IN; }
        __syncthreads();
        for (int idx = F.tid; idx < NB * DM / 4; idx += NWAVES * 64) { const int b = idx >> 9, k = (idx & 511) * 4; const f32x4 v = *(const GAS f32x4*)(sh + (size_t)b * MODW + k);
            u32x2 w; w.x = pk2(v.x, v.y); w.y = pk2(v.z, v.w); *(LAS u32x2*)(shL + b * DM + k) = w; }
        __syncthreads();
        float* dst = (float*)(ws + WS_SHW) + (size_t)site * NB * 8192;
        for (int t = wi; t < N / 32; t += nwi) {
            const GAS bf16* brow = (const GAS bf16*)Wt + (size_t)(t * 32 + r) * DM + 8 * hi;
            f32x16 acc = {};
#pragma unroll 1
            for (int k0 = 0; k0 < DM; k0 += 256) {
                bf16x8 bb[16];
#pragma unroll
                for (int q = 0; q < 16; ++q) bb[q] = *(const GAS bf16x8*)(brow + k0 + 16 * q);
#pragma unroll
                for (int q = 0; q < 16; ++q) { bf16x8 a = *(const LAS bf16x8*)(shL + (r & 7) * DM + k0 + 16 * q + 8 * hi); if (r >= 8) a = (bf16x8){0, 0, 0, 0, 0, 0, 0, 0};
                    acc = mfma32(a, bb[q], acc); }
            }
#pragma unroll
            for (int rg = 0; rg < 4; ++rg) dst[(size_t)(rg + 4 * hi) * 8192 + t * 32 + r] = acc[rg];
        }
    }
    __syncthreads();
}

DEVI bf16x8 add_pos8(v4u a, f32x4 p0, f32x4 p1) {
    v4u o; o.x = pk2(bflo(a.x) + p0.x, bfhi(a.x) + p0.y); o.y = pk2(bflo(a.y) + p0.z, bfhi(a.y) + p0.w); o.z = pk2(bflo(a.z) + p1.x, bfhi(a.z) + p1.y); o.w = pk2(bflo(a.w) + p1.z, bfhi(a.w) + p1.w);
    return __builtin_bit_cast(bf16x8, o);
}
DEVI void compress_unit(const Ctx& F, unsigned char* ws, int j, int u) {
    const int per = F.NBS * 16, kv = u / per, ur = u - kv * per, b = F.b0 + (ur >> 4), g = (ur >> 2) & 3, n0 = (ur & 3) * 32;
    const int lane = F.lane, w = F.wave, r = lane & 31, hi = lane >> 5;
    const bf16* raw = (const bf16*)(ws + WS_RAW);
    const GAS float* pos = (const GAS float*)inp(F, 13) + (size_t)(j * 2 + kv) * 4096;
    const bf16* W1t = (const bf16*)(ws + WS_CW1) + (size_t)(j * 2 + kv) * 256 * 4096;
    const bf16* W2t = (const bf16*)(ws + WS_CW2) + (size_t)(j * 2 + kv) * 128 * 256;
    constexpr int AROW = 136, ABUF = 4 * 32 * AROW * 2;
    LAS bf16* abuf = (LAS bf16*)(F.lds);
    LAS bf16* hidL = (LAS bf16*)(F.lds + 2 * ABUF);
    LAS float* outL = (LAS float*)(F.lds + 2 * ABUF + 32768);
    const int sl4 = F.tid >> 7, sn = (F.tid >> 2) & 31, sq = F.tid & 3, snn = n0 + sn; const bool sok = snn <= 126;
    const GAS bf16* asrc = (const GAS bf16*)raw + (size_t)(b * T + 16 * (sok ? snn : 0) + sl4) * NSA_INP + 2048 + kv * 512 + g * 128 + 32 * sq;
    const GAS float* psrc = pos + sl4 * 128 + 32 * sq;
    v4u ar[4]; f32x4 pr[8];
#define CMP_ALOAD(lg) do { _Pragma("unroll") for (int c = 0; c < 4; ++c) { ar[c] = *(const GAS v4u*)(asrc + (size_t)(4 * (lg)) * NSA_INP + 8 * c); \
        pr[2 * c] = *(const GAS f32x4*)(psrc + (lg) * 512 + 8 * c); pr[2 * c + 1] = *(const GAS f32x4*)(psrc + (lg) * 512 + 8 * c + 4); } } while (0)
#define CMP_AWRITE(lg, buf) do { _Pragma("unroll") for (int c = 0; c < 4; ++c) { \
        bf16x8 a = add_pos8(ar[c], pr[2 * c], pr[2 * c + 1]); if (!sok) a = (bf16x8){0, 0, 0, 0, 0, 0, 0, 0}; *(LAS bf16x8*)(abuf + (buf) * (ABUF / 2) + (sl4 * 32 + sn) * AROW + 32 * sq + 8 * c) = a; } } while (0)
    const GAS bf16* brow = (const GAS bf16*)W1t + (size_t)w * (8 * 32 * 512) + lane * 8;
    f32x16 acc = {};
    bf16x8 bA[16], bB[16];
#pragma unroll
    for (int q = 0; q < 16; ++q) bA[q] = *(const GAS bf16x8*)(brow + q * 512);
    CMP_ALOAD(0); CMP_AWRITE(0, 0);
    __syncthreads();
#pragma unroll 1
    for (int lg = 0; lg < 8; ++lg) {
#pragma unroll
        for (int q = 0; q < 16; ++q) bB[q] = *(const GAS bf16x8*)(brow + (lg * 32 + 16 + q) * 512);
        if (lg < 7) CMP_ALOAD(lg + 1);
        const LAS bf16* ab = abuf + (lg & 1) * (ABUF / 2) + r * AROW + 8 * hi;
#pragma unroll
        for (int q = 0; q < 16; ++q) acc = mfma32(*(const LAS bf16x8*)(ab + (q >> 3) * 32 * AROW + (q & 7) * 16), bA[q], acc);
        if (lg < 7) {
#pragma unroll
            for (int q = 0; q < 16; ++q) bA[q] = *(const GAS bf16x8*)(brow + ((lg + 1) * 32 + q) * 512); }
#pragma unroll
        for (int q = 16; q < 32; ++q) acc = mfma32(*(const LAS bf16x8*)(ab + (q >> 3) * 32 * AROW + (q & 7) * 16), bB[q - 16], acc);
        if (lg < 7) CMP_AWRITE(lg + 1, (lg + 1) & 1);
        __syncthreads();
    }
#undef CMP_ALOAD
#undef CMP_AWRITE
    bf16x8 w2f[16];
    if (w < 4) { const GAS bf16* b2 = (const GAS bf16*)W2t + (size_t)(32 * w + r) * 256 + 8 * hi;
#pragma unroll
        for (int q = 0; q < 16; ++q) w2f[q] = *(const GAS bf16x8*)(b2 + 16 * q); }
    __builtin_amdgcn_sched_barrier(0);
#pragma unroll
    for (int rg = 0; rg < 16; ++rg) { const float v = acc[rg]; hidL[crow(rg, hi) * 264 + 32 * w + r] = (bf16)f2bf(v / (1.f + expf(-v))); }
    __syncthreads();
    if (w < 4) {
        f32x16 a2 = {};
#pragma unroll
        for (int q = 0; q < 16; ++q) { const bf16x8 a = *(const LAS bf16x8*)(hidL + r * 264 + 16 * q + 8 * hi); a2 = mfma32(a, w2f[q], a2); }
#pragma unroll
        for (int rg = 0; rg < 16; ++rg) outL[crow(rg, hi) * 132 + 32 * w + r] = a2[rg];
    }
    __syncthreads();
    if (kv == 0) {
        if (F.tid < 256) { const int row = F.tid >> 3, c = F.tid & 7, nn = n0 + row;
            bf16* dst = (bf16*)(ws + WS_KCMP) + ((size_t)(b * 4 + g) * 128 + nn) * 128;
            v4u oa = {0u, 0u, 0u, 0u}, ob = oa;
            float x1[8], x2[8]; float ss = 0.f;
#pragma unroll
            for (int i = 0; i < 8; ++i) { x1[i] = outL[row * 132 + 8 * c + i]; x2[i] = outL[row * 132 + 64 + 8 * c + i]; ss += x1[i] * x1[i] + x2[i] * x2[i]; }
            ss += __shfl_xor(ss, 1); ss += __shfl_xor(ss, 2); ss += __shfl_xor(ss, 4);
            if (nn <= 126) {
                const float rstd = 1.f / sqrtf(ss * (1.f / 128.f) + EPS);
                const float* gamma = inp(F, 12) + j * 384;
                const unsigned* rp = (const unsigned*)(ws + WS_ROPE) + (size_t)(b * T + 16 * nn + 31) * 64 + 8 * c;
                float o1[8], o2[8];
#pragma unroll
                for (int i = 0; i < 8; ++i) { const float y1 = x1[i] * rstd * gamma[8 * c + i], y2 = x2[i] * rstd * gamma[64 + 8 * c + i], co = pg8::f16lo(rp[i]), si = pg8::f16hi(rp[i]);
                    o1[i] = y1 * co - y2 * si; o2[i] = y2 * co + y1 * si; }
                oa.x = pk2(o1[0], o1[1]); oa.y = pk2(o1[2], o1[3]); oa.z = pk2(o1[4], o1[5]); oa.w = pk2(o1[6], o1[7]);
                ob.x = pk2(o2[0], o2[1]); ob.y = pk2(o2[2], o2[3]); ob.z = pk2(o2[4], o2[5]); ob.w = pk2(o2[6], o2[7]);
            }
            *(GAS v4u*)(dst + 8 * c) = oa; *(GAS v4u*)(dst + 64 + 8 * c) = ob; }
    } else {
        const int d = F.tid >> 2, nc = F.tid & 3;
        bf16* dst = (bf16*)(ws + WS_VCMP) + ((size_t)(b * 4 + g) * 128 + d) * 128 + n0 + 8 * nc;
        float v[8];
#pragma unroll
        for (int i = 0; i < 8; ++i) v[i] = (n0 + 8 * nc + i <= 126) ? outL[(8 * nc + i) * 132 + d] : 0.f;
        v4u o; o.x = pk2(v[0], v[1]); o.y = pk2(v[2], v[3]); o.z = pk2(v[4], v[5]); o.w = pk2(v[6], v[7]);
        *(GAS v4u*)dst = o;
    }
    __syncthreads();
}

DEVI void cmpattn_phase(const Ctx& F, unsigned char* ws) {
    const int lane = F.lane, w = F.wave, r = lane & 31, hi = lane >> 5, hl = w >> 1;
    LAS float* SL = (LAS float*)(F.lds);
    LAS bf16* PL = (LAS bf16*)(F.lds + 67584);
    LAS bf16* KL = (LAS bf16*)(F.lds + 102400);
    const bf16* qhm = (const bf16*)(ws + WS_QHM); const bf16* kcmp = (const bf16*)(ws + WS_KCMP); const bf16* vcmp = (const bf16*)(ws + WS_VCMP);
    constexpr float L2E = 1.4426950408889634f;
    for (int grp = F.vcu; grp < 32 * F.NBS; grp += F.G) {
        const int b = F.b0 + (grp >> 5), g = (grp >> 3) & 3, qt0 = (grp & 7) * 8;
        bf16x8 vf[2][8], qf[8];
        __syncthreads();
        { const GAS bf16* kg = (const GAS bf16*)kcmp + (size_t)(b * 4 + g) * 128 * 128;
          const GAS bf16* ksrc = kg + (F.tid >> 4) * 128 + (F.tid & 15) * 8; LAS bf16* kdst = KL + (F.tid >> 4) * 136 + (F.tid & 15) * 8; bf16x8 kt4[4];
#pragma unroll
          for (int c = 0; c < 4; ++c) kt4[c] = *(const GAS bf16x8*)(ksrc + c * 32 * 128);
#pragma unroll
          for (int c = 0; c < 4; ++c) *(LAS bf16x8*)(kdst + c * 32 * 136) = kt4[c]; }
#pragma unroll
        for (int kk = 0; kk < 2; ++kk) { const int t2 = (w & 1) * 2 + kk;
            const GAS bf16* vrow = (const GAS bf16*)vcmp + ((size_t)(b * 4 + g) * 128 + t2 * 32 + r) * 128 + 8 * hi;
#pragma unroll
            for (int d0 = 0; d0 < 8; ++d0) vf[kk][d0] = *(const GAS bf16x8*)(vrow + d0 * 16); }
        __syncthreads();
        const GAS bf16* qbase = (const GAS bf16*)qhm + ((size_t)(b * 16 + g * 4 + hl) * T + r) * 128 + 8 * hi;
#pragma unroll
        for (int d0 = 0; d0 < 8; ++d0) qf[d0] = *(const GAS bf16x8*)(qbase + (size_t)(qt0 * 32) * 128 + d0 * 16);
#pragma unroll 1
        for (int qi8 = 0; qi8 < 8; ++qi8) {
            const int t0 = (qt0 + qi8) * 32;
#pragma unroll
            for (int kk = 0; kk < 2; ++kk) { const int kt = (w & 1) * 2 + kk;
                f32x16 acc = {};
#pragma unroll
                for (int d0 = 0; d0 < 8; ++d0) acc = mfma32(qf[d0], *(const LAS bf16x8*)(KL + (kt * 32 + r) * 136 + d0 * 16 + 8 * hi), acc);
#pragma unroll
                for (int rg = 0; rg < 16; ++rg) SL[(hl * 32 + crow(rg, hi)) * 132 + kt * 32 + r] = acc[rg]; }
            if (qi8 < 7) {
#pragma unroll
                for (int d0 = 0; d0 < 8; ++d0) qf[d0] = *(const GAS bf16x8*)(qbase + (size_t)(t0 + 32) * 128 + d0 * 16); }
            __syncthreads();
            { const int row = F.tid >> 2, part = F.tid & 3, t = t0 + (row & 31), nmax = t >= 31 ? ((t - 31) >> 4) : -1;
              float v[32]; float mx = -__builtin_inff();
#pragma unroll
              for (int i = 0; i < 32; ++i) { const int n = part + 4 * i; const float s = SL[row * 132 + n] * (fa::SCALE * L2E); v[i] = n <= nmax ? s : -__builtin_inff(); mx = fmaxf(mx, v[i]); }
              mx = fmaxf(mx, __shfl_xor(mx, 1)); mx = fmaxf(mx, __shfl_xor(mx, 2));
              float sum = 0.f;
#pragma unroll
              for (int i = 0; i < 32; ++i) { const int n = part + 4 * i; v[i] = n <= nmax ? __builtin_amdgcn_exp2f(v[i] - mx) : 0.f; sum += v[i]; }
              sum += __shfl_xor(sum, 1); sum += __shfl_xor(sum, 2);
              const float inv = sum > 0.f ? 1.f / sum : 0.f;
#pragma unroll
              for (int i = 0; i < 32; ++i) { const int n = part + 4 * i; const float p = v[i] * inv; SL[row * 132 + n] = p; PL[row * 136 + n] = (bf16)f2bf(p); } }
            __syncthreads();
            { const int s = lane & 31, qa = 2 * w + hi;
#pragma unroll
              for (int rep = 0; rep < 2; ++rep) { const int qi = qa + 16 * rep, t = t0 + qi, tb = t >> 6;
                  float imp = 0.f;
#pragma unroll
                  for (int h4 = 0; h4 < 4; ++h4) { const LAS float* p = SL + (h4 * 32 + qi) * 132 + 4 * s;
                      imp += (s > 0 ? p[-1] : 0.f) + 2.f * p[0] + 2.f * p[1] + 2.f * p[2] + p[3]; }
                  const bool forced = (s == 0) || (s == tb) || (s == tb - 1), valid = s <= tb;
                  const float val = forced ? 1e30f : (valid ? imp : -1e30f);
                  int rank = 0;
#pragma unroll
                  for (int s2 = 0; s2 < 32; ++s2) { const float o = __shfl(val, (lane & 32) + s2); rank += (o > val || (o == val && s2 < s)) ? 1 : 0; }
                  const unsigned long long bal = __ballot(rank < 16);
                  if (s == 0) ((unsigned*)(ws + WS_SEL))[(size_t)(b * 4 + g) * T + t] = (unsigned)(bal >> (lane & 32)); } }
            { bf16* ocmp = (bf16*)(ws + WS_O0);
              f32x16 oacc[2];
#pragma unroll
              for (int kk = 0; kk < 2; ++kk) { oacc[kk] = (f32x16){};
#pragma unroll
                  for (int k0 = 0; k0 < 8; ++k0) oacc[kk] = mfma32(*(const LAS bf16x8*)(PL + (hl * 32 + r) * 136 + k0 * 16 + 8 * hi), vf[kk][k0], oacc[kk]); }
              __syncthreads();
              LAS unsigned char* ost = F.lds + w * 4608;
#pragma unroll
              for (int kk = 0; kk < 2; ++kk)
#pragma unroll
                  for (int rg = 0; rg < 16; ++rg) *(LAS bf16*)(ost + crow(rg, hi) * 144 + (kk * 32 + r) * 2) = (bf16)f2bf(oacc[kk][rg]);
              LDS_WAIT();
#pragma unroll
              for (int it = 0; it < 4; ++it) { const int row = it * 8 + (lane >> 3), cb = (lane & 7) * 16;
                  const v4u o4 = *(const LAS v4u*)(ost + row * 144 + cb);
                  *(GAS v4u*)((GAS unsigned char*)(ocmp + (size_t)(b * T + t0 + row) * DM + (g * 4 + hl) * 128 + (w & 1) * 64) + cb) = o4; } }
            __syncthreads();
        }
    }
}

DEVI void gates_finalize(const Ctx& F, unsigned char* ws, int site) {
    const float* gp = (const float*)(ws + WS_GP); const float* ssq = (const float*)(ws + WS_SSQ); const float* shw = (const float*)(ws + WS_SHW); float* gates = (float*)(ws + WS_GATES);
    const int gt = F.gw * 64 + F.lane, GT = F.NGW * 64;
    for (int idx = F.m0 * 12 + gt; idx < (F.m0 + F.MS) * 12; idx += GT) { const int row = idx / 12, c0 = (idx - row * 12) * 4;
        const f32x4 q0 = *(const GAS f32x4*)(ssq + (size_t)row * 8), q1 = *(const GAS f32x4*)(ssq + (size_t)row * 8 + 4);
        const float rs = 1.0f / sqrtf((((q0.x + q0.y) + (q0.z + q0.w)) + ((q1.x + q1.y) + (q1.z + q1.w))) * (1.0f / 2048.0f) + 1e-6f);
        f32x4 pa[4];
#pragma unroll
        for (int kq = 0; kq < 4; ++kq) pa[kq] = *(const GAS f32x4*)(gp + (size_t)kq * ((size_t)M * 48) + (size_t)row * 48 + c0);
        const f32x4 bv = *(const GAS f32x4*)(shw + ((size_t)site * NB + (row >> 11)) * 8192 + 5120 + c0);
        __builtin_amdgcn_sched_barrier(0);
        const f32x4 a = (pa[0] + pa[1]) + (pa[2] + pa[3]);
#pragma unroll
        for (int i = 0; i < 4; ++i) { const int c = c0 + i; gates[((size_t)row * 16 + (c & 15)) * 4 + (c >> 4)] = 1.0f / (1.0f + __expf(-(a[i] * rs + bv[i]))); } }
}
DEVI void nsa_combine(const Ctx& F, unsigned char* ws) {
    const bf16* o0 = (const bf16*)(ws + WS_O0); const bf16* o1 = o0 + (size_t)M * DM; const bf16* o2 = o1 + (size_t)M * DM; const float* gates = (const float*)(ws + WS_GATES); bf16* ao = (bf16*)(ws + WS_AO);
    const int gt = F.gw * 64 + F.lane, GT = F.NGW * 64;
    for (int idx = F.m0 * (DM / 8) + gt; idx < (F.m0 + F.MS) * (DM / 8); idx += GT) { const int m = idx >> 8, col = (idx & 255) * 8, h = col >> 7;
        const f32x4 g4 = *(const GAS f32x4*)(gates + ((size_t)m * 16 + h) * 4); const float g0 = MK_CMPPROBE ? 0.f : g4.x, g1 = g4.y, g2 = g4.z;
        const size_t off = (size_t)m * DM + col;
        const v4u a = *(const GAS v4u*)(o0 + off), bb = *(const GAS v4u*)(o1 + off), cc = *(const GAS v4u*)(o2 + off);
        v4u o;
        o.x = pk2(g0 * bflo(a.x) + g1 * bflo(bb.x) + g2 * bflo(cc.x), g0 * bfhi(a.x) + g1 * bfhi(bb.x) + g2 * bfhi(cc.x));
        o.y = pk2(g0 * bflo(a.y) + g1 * bflo(bb.y) + g2 * bflo(cc.y), g0 * bfhi(a.y) + g1 * bfhi(bb.y) + g2 * bfhi(cc.y));
        o.z = pk2(g0 * bflo(a.z) + g1 * bflo(bb.z) + g2 * bflo(cc.z), g0 * bfhi(a.z) + g1 * bfhi(bb.z) + g2 * bfhi(cc.z));
        o.w = pk2(g0 * bflo(a.w) + g1 * bflo(bb.w) + g2 * bflo(cc.w), g0 * bfhi(a.w) + g1 * bfhi(bb.w) + g2 * bfhi(cc.w));
        *(GAS v4u*)(ao + off) = o; }
}
DEVI void diff_combine(const Ctx& F, unsigned char* ws, int j, int layer) {
    const bf16* oraw = (const bf16*)(ws + WS_O0); bf16* ao = (bf16*)(ws + WS_AO);
    const float* lp = inp(F, 20) + j * 512; const float* sg = inp(F, 21) + j * 256;
    int ly_ = layer; asm volatile("" : "+s"(ly_));
    const float lam_init = ly_ == 1 ? 0.35550906759096934f : 0.5560582041556406f;
    const float s01 = wave_sum(lp[F.lane] * lp[128 + F.lane] + lp[64 + F.lane] * lp[192 + F.lane]);
    const float s23 = wave_sum(lp[256 + F.lane] * lp[384 + F.lane] + lp[320 + F.lane] * lp[448 + F.lane]);
    const float lam = expf(s01) - expf(s23) + lam_init;
    const float osc = 1.f - lam_init;
    const int l5 = F.lane & 31, e0 = l5 * 8;
    const f32x4 ga = *(const GAS f32x4*)(sg + e0), gb = *(const GAS f32x4*)(sg + e0 + 4);
    const int pend = (F.m0 + F.MS) * 4;
#pragma unroll 1
    for (int pp0 = F.m0 * 4 + F.gw; pp0 < pend; pp0 += 4 * F.NGW) {
        v4u a[4], bb[4];
#pragma unroll
        for (int u = 0; u < 4; ++u) { const int pp = pp0 + u * F.NGW; if (pp < pend) { const int mh = pp * 2 + (F.lane >> 5), m = mh >> 3, h = mh & 7;
            a[u] = *(const GAS v4u*)(oraw + (size_t)m * 4096 + (2 * h) * 256 + e0); bb[u] = *(const GAS v4u*)(oraw + (size_t)m * 4096 + (2 * h + 1) * 256 + e0); } }
#pragma unroll
        for (int u = 0; u < 4; ++u) { const int pp = pp0 + u * F.NGW; if (pp < pend) { const int mh = pp * 2 + (F.lane >> 5), m = mh >> 3, h = mh & 7;
            float o[8];
            o[0] = bflo(a[u].x) - lam * bflo(bb[u].x); o[1] = bfhi(a[u].x) - lam * bfhi(bb[u].x); o[2] = bflo(a[u].y) - lam * bflo(bb[u].y); o[3] = bfhi(a[u].y) - lam * bfhi(bb[u].y);
            o[4] = bflo(a[u].z) - lam * bflo(bb[u].z); o[5] = bfhi(a[u].z) - lam * bfhi(bb[u].z); o[6] = bflo(a[u].w) - lam * bflo(bb[u].w); o[7] = bfhi(a[u].w) - lam * bfhi(bb[u].w);
            float ss = 0.f;
#pragma unroll
            for (int i = 0; i < 8; ++i) ss += o[i] * o[i];
            ss += __shfl_xor(ss, 1); ss += __shfl_xor(ss, 2); ss += __shfl_xor(ss, 4); ss += __shfl_xor(ss, 8); ss += __shfl_xor(ss, 16);
            const float rs = osc / sqrtf(ss * (1.f / 256.f) + EPS);
            v4u w; w.x = pk2(o[0] * rs * ga.x, o[1] * rs * ga.y); w.y = pk2(o[2] * rs * ga.z, o[3] * rs * ga.w); w.z = pk2(o[4] * rs * gb.x, o[5] * rs * gb.y); w.w = pk2(o[6] * rs * gb.z, o[7] * rs * gb.w);
            *(GAS v4u*)(ao + (size_t)m * DM + h * 256 + e0) = w; } }
    }
}

typedef fa::BlockRef<bf16, bf16> FaRef;
struct FaItem { const bf16* Q; const bf16* K; const bf16* V; bf16* O; const unsigned* sel; const float* gates; int W, os, qb0, qb1, pk; };
constexpr int FA_BIGW = 1 << 20;
__device__ const unsigned FA_POS[8] = {
    31u | 30u << 8 | 6u << 16 | 0u << 24, 29u | 28u << 8 | 7u << 16 | 1u << 24, 27u | 26u << 8 | 8u << 16 | 2u << 24, 25u | 24u << 8 | 10u << 16 | 3u << 24,
    23u | 22u << 8 | 13u << 16 | 4u << 24, 21u | 20u << 8 | 15u << 16 | 5u << 24, 19u | 18u << 8 | 12u << 16 | 9u << 24, 17u | 16u << 8 | 14u << 16 | 11u << 24 };
DEVI FaItem fa_item(unsigned char* ws, bool nsa, int L, int b0, int nbs) {
    FaItem it; const bf16* qhm = (const bf16*)(ws + WS_QHM); const bf16* ka = (const bf16*)(ws + WS_KA); bf16* o0 = (bf16*)(ws + WS_O0);
    if (nsa) {
        const int per = 32 * nbs, cu = L % per, k = L / per, bgl = cu >> 3, jj = cu & 7, b = b0 + (bgl >> 2), g = bgl & 3, bg = b * 4 + g;
        const int qb = (int)((FA_POS[jj] >> (8 * (k & 3))) & 255u);
        it.Q = qhm + (size_t)(b * 16 + 4 * g) * T * 128; it.os = DM; it.pk = 1; it.qb0 = qb; it.qb1 = qb;
        if (k < 4) {
            it.K = ka + (size_t)bg * T * 128; it.V = ka + (size_t)2 * (8 * MiB) + (size_t)bg * T * 128;
            it.O = o0 + (size_t)M * DM + (size_t)b * T * DM + g * 512; it.sel = MK_NOSEL ? nullptr : (const unsigned*)(ws + WS_SEL) + (size_t)bg * T; it.W = FA_BIGW; it.gates = nullptr; }
        else {
            it.K = ka + (size_t)1 * (8 * MiB) + (size_t)bg * T * 128; it.V = ka + (size_t)3 * (8 * MiB) + (size_t)bg * T * 128; it.sel = nullptr; it.W = MK_WINPROBE ? FA_BIGW : 512;
            if (MK_FUSEC) { it.O = (bf16*)(ws + WS_AO) + (size_t)b * T * DM + g * 512; it.gates = (const float*)(ws + WS_GATES) + ((size_t)b * T * 16 + 4 * g) * 4; }
            else { it.O = o0 + (size_t)2 * M * DM + (size_t)b * T * DM + g * 512; it.gates = nullptr; } }
    } else { const int bhh = L >> 2, x = L & 3, b = b0 + (bhh >> 5), hc = (bhh >> 1) & 15, half = bhh & 1;
        it.Q = qhm + (size_t)(b * 16 + hc) * T * 128; it.K = ka + (size_t)(b * 16 + hc) * T * 128; it.V = (const bf16*)(ws + WS_VA) + (size_t)((b * 8 + (hc >> 1)) * 2 + half) * T * 128;
        it.O = o0 + (size_t)b * T * 4096 + (hc * 2 + half) * 128; it.sel = nullptr; it.W = FA_BIGW; it.os = 4096; it.qb0 = x; it.qb1 = 7 - x; it.pk = 0; it.gates = nullptr; }
    return it;
}
DEVI FaRef fa_ref(const FaItem& it, int pass) {
    const int qb = pass ? it.qb1 : it.qb0, p0 = qb * (it.pk ? 64 : 256); FaRef r;
    r.Q = it.Q + (size_t)p0 * 128; r.K = it.K; r.V = it.V; r.O = it.O + (size_t)p0 * it.os; r.sel = it.sel; r.P0 = p0; r.W = it.W; r.os = it.os; r.pk = it.pk;
    return r;
}
struct FaNext { unsigned char* ws; bool nsa; int L, pass, b0, nbs;
    DEVI FaRef operator()() const { int l = L, p = pass; asm volatile("" : "+s"(l), "+s"(p)); const FaItem it = fa_item(ws, nsa, l, b0, nbs); return fa_ref(it, p); } };
struct FaOut { unsigned char* ws; bool nsa; int L, pass, b0, nbs;
    DEVI fa::OutRef<bf16> operator()() const { int l = L, p = pass; asm volatile("" : "+s"(l), "+s"(p)); const FaItem it = fa_item(ws, nsa, l, b0, nbs); const FaRef r = fa_ref(it, p); fa::OutRef<bf16> o; o.O = r.O; o.os = r.os; o.pk = r.pk; o.gates = it.gates ? it.gates + (size_t)r.P0 * 64 : nullptr; o.dC = (long)WS_O0 - (long)WS_AO; o.dS = o.dC + (long)M * DM * 2; return o; } };
DEVI void flash_phase(const Ctx& F, unsigned char* ws, bool nsa) {
    const int total = nsa ? 256 * F.NBS : 128 * F.NBS, stride = F.G;
    int L = F.vcu; if (L >= total) return;
    int pass = 0;
    fa::Seam<bf16> S;
    { const FaItem it = fa_item(ws, nsa, L, F.b0, F.NBS); const FaRef cur = fa_ref(it, 0); fa::causal_swa_prime<bf16, bf16>(cur, F.ldsg, S, F.wave); }
    for (;;) {
        const FaItem it = fa_item(ws, nsa, L, F.b0, F.NBS); const FaRef cur = fa_ref(it, pass);
        const bool more_pass = pass == 0 && it.qb1 != it.qb0, more_item = L + stride < total, last = !more_pass && !more_item;
        int Ln = L, passn = pass;
        if (more_pass) passn = 1; else if (more_item) { Ln = L + stride; passn = 0; }
        const FaNext nx{ws, nsa, Ln, passn, F.b0, F.NBS}; const FaOut ox{ws, nsa, L, pass, F.b0, F.NBS};
        fa::causal_swa_block<bf16, bf16, FaNext, FaOut>(cur, nx, ox, T, F.ldsg, S, F.wave);
        if (last) break;
        L = Ln; pass = passn;
    }
}

constexpr int PH_STEP0 = 3, PH_PER_STEP = 6, NPH = PH_STEP0 + 8 * PH_PER_STEP;
struct Args { const float* in[22]; float* out; unsigned char* ws; int ph_lo, ph_hi; };
__global__ void __launch_bounds__(NWAVES * 64, 2) mk_fwd(Args args) {
    extern __shared__ __attribute__((aligned(16))) unsigned char lds[];
    const int wv0 = __builtin_amdgcn_readfirstlane(threadIdx.x >> 6);
    Ctx F;
    int split = 0;
#define MKCTX() do { F.lds = (LAS unsigned char*)lds; F.ldsg = (char*)lds; F.tid = opaque_tid(wv0); F.lane = F.tid & 63; F.wave = __builtin_amdgcn_readfirstlane(F.tid >> 6); \
        F.G = gridDim.x; F.bid = opaque_bid(); F.m0 = 0; F.MS = M; F.b0 = 0; F.NBS = NB; \
        if (split) { const int st_ = F.bid & 7; F.bid >>= 3; F.G >>= 3; F.m0 = st_ * T; F.MS = T; F.b0 = st_; F.NBS = 1; } \
        F.vcu = (F.G % 8 == 0) ? (F.bid % 8) * (F.G / 8) + F.bid / 8 : F.bid; F.gw = F.vcu * NWAVES + F.wave; F.NGW = F.G * NWAVES; } while (0)
    MKCTX();
    unsigned char* ws = args.ws;
    const int lo = args.ph_lo, hi = args.ph_hi;
    const bool use_bar = (MK_N_LAUNCHES == 1) ? true : (hi - lo) > 1;
    volatile LAS unsigned* MISC = (volatile LAS unsigned*)(F.lds + MISC_OFF);
    for (int u = F.tid; u < (LDS_BYTES - LDSCTL_OFF) / 4; u += NWAVES * 64) ((LAS unsigned*)(F.lds + LDSCTL_OFF))[u] = 0u;
    __syncthreads();
    if (F.tid == 0) {
#pragma unroll
        for (int k = 0; k < 22; ++k) ((LAS unsigned long long*)(F.lds + PTR_OFF))[k] = (unsigned long long)args.in[k]; }
    __syncthreads();
    const bool dual = MK_DUAL && (MK_N_LAUNCHES == 1 || (lo == 0 && hi == NPH)) && (gridDim.x % 64) == 0;
    const int stream = dual ? ((int)blockIdx.x & 7) : 0;
    if (use_bar) (void)xcd_barrier_post((unsigned*)(ws + WS_CTL) + CW_BAR, MISC + 8, gridDim.x);
    if (dual) (void)xcd_barrier_post((unsigned*)(ws + WS_CTL) + CW_BAR + (1 + stream) * XCD_BAR_WORDS, MISC + 12, gridDim.x / 8);
#define GRID_SYNC() do { XcdBarrier b_; const int sp_ = split; b_.bar = (unsigned*)(ws + WS_CTL) + CW_BAR + (sp_ ? (1 + stream) * XCD_BAR_WORDS : 0); b_.x = xb_xcc_id(); \
        b_.st = (volatile LAS unsigned*)((LAS unsigned char*)lds + MISC_OFF) + (sp_ ? 12 : 8); b_.G = gridDim.x >> (3 * sp_); xcd_barrier(b_); } while (0)
#if MK_N_LAUNCHES == 1
#define IN(k) true
#else
#define IN(k) (lo <= (k) && (k) < hi)
#endif
#ifndef MK_STAG0
#define MK_STAG0 0
#endif
#ifndef MK_STAG5
#define MK_STAG5 0
#endif
#define STAGGER(ticks) do { if ((ticks) > 0 && (F.vcu & 1)) { const unsigned long long t0_ = __builtin_amdgcn_s_memrealtime(); while (__builtin_amdgcn_s_memrealtime() - t0_ < (unsigned long long)(ticks)) __builtin_amdgcn_s_sleep(8); } } while (0)
#ifndef MK_DBLBAR
#define MK_DBLBAR 0
#endif
#ifndef MK_IDLEPROBE
#define MK_IDLEPROBE 0
#endif
#define IDLE_SEL(k) (MK_IDLEPROBE == 1 || (MK_IDLEPROBE == 2 && (k) >= PH_STEP0 && (((k) - PH_STEP0) % PH_PER_STEP == 0 || ((k) - PH_STEP0) % PH_PER_STEP == 5)) || (MK_IDLEPROBE == 3 && (k) >= PH_STEP0 && ((k) - PH_STEP0) % PH_PER_STEP == 3))
#define SEAM(k) do { if (use_bar && IN((k) + 1)) { const bool pr_ = MK_IDLEPROBE && IDLE_SEL(k); if (pr_ && opaque_tid(wv0) == 0) ((volatile LAS unsigned*)((LAS unsigned char*)lds + MISC_OFF))[17] = (unsigned)__builtin_amdgcn_s_memrealtime(); GRID_SYNC(); if (pr_ && opaque_tid(wv0) == 0) { volatile LAS unsigned* q_ = (volatile LAS unsigned*)((LAS unsigned char*)lds + MISC_OFF); q_[16] += (unsigned)__builtin_amdgcn_s_memrealtime() - q_[17]; } if (MK_DBLBAR) GRID_SYNC(); } } while (0)

    if (IN(0)) { MKCTX(); for (int rp = 0; rp < REPN(0); ++rp) { if (EN(0)) p0_prologue(F, ws, 0); __syncthreads(); } SEAM(0); }
    if (IN(1)) { MKCTX(); p1_mod(F, ws); SEAM(1); }
    if (IN(2)) { MKCTX(); for (int rp = 0; rp < REPN(9); ++rp) p2_first(F, ws); SEAM(2); }
    if (dual) split = 1;

    for (int s = 0; s < 8; ++s) {
        const int layer = s >> 1, half = s & 1, j = layer >> 1, pb = PH_STEP0 + s * PH_PER_STEP;
        const bool nsa = (layer & 1) == 0;
        const int nhf = (MK_HSPLIT && use_bar) ? half + 1 : 1;
        for (int hf = 0; hf < nhf; ++hf) {
        if (IN(pb + 0)) { MKCTX();
            const int rn = F.MS / nhf, r0 = F.m0 + hf * rn, hrow0 = nhf == 2 ? (F.m0 >> 1) : r0;
            pg8::Gemm g; g.A = (const bf16*)(ws + WS_H) + (size_t)r0 * DM; g.M = rn; g.K = DM; g.ld = DM;
            if (half == 0) {
                pg8::EpiQKV E; E.ws = ws; E.lds = F.lds; E.site = s; E.j = j; E.nsa = nsa ? 1 : 0; E.m0 = F.m0; E.b0 = F.b0;
                if (nsa) { g.Bt = (const bf16*)(ws + WS_NWIN) + (size_t)j * NSA_INP * DM; g.N = NSA_INP - 256; } else { g.Bt = (const bf16*)(ws + WS_DWIN) + (size_t)j * DIFF_IN * DM; g.N = DIFF_IN; }
                pg8::StaticOrder S; S.init(g.M, g.N, F.G, F.bid);
                STAGGER(MK_STAG0);
                for (int rp = 0; rp < REPN(1); ++rp) { if (EN(1)) pg8::gemm_phase<pg8::EpiQKV, pg8::StaticOrder, true, MK_SP2A>(F.lds, g, S, E, F.wave); __syncthreads(); }
                if (nsa) { pg8::EpiGatesP EG; EG.ws = ws; EG.m0 = F.m0; pg8::Gemm g2 = g; g2.K = DM / 4;
                    pg8::SplitKOrder S2; S2.init(g.M, (NSA_INP - 256) / 256, DM / 4, F.G, F.bid);
                    pg8::gemm_phase<pg8::EpiGatesP, pg8::SplitKOrder, true, MK_SP2A>(F.lds, g2, S2, EG, F.wave); __syncthreads(); }
            } else {
                pg8::EpiStore E; E.ws = ws; E.lds = F.lds; E.site = s; E.m0 = r0; E.b0 = F.b0; E.hrow0 = hrow0;
                g.Bt = (const bf16*)(ws + WS_W1T) + (size_t)layer * DFF * DM; g.N = DFF;
                pg8::StaticOrder S; S.init(g.M, g.N, F.G, F.bid);
                STAGGER(MK_STAG0);
                for (int rp = 0; rp < REPN(1); ++rp) {
                    if (MK_NULLEPI && rp + 1 < REPN(1)) { pg8::EpiNull E0; pg8::gemm_phase<pg8::EpiNull, pg8::StaticOrder, true, true>(F.lds, g, S, E0, F.wave); }
                    else if (EN(1)) pg8::gemm_phase<pg8::EpiStore, pg8::StaticOrder, true, MK_SP2A>(F.lds, g, S, E, F.wave);
                    __syncthreads(); }
            }
            SEAM(pb + 0);
        }
        if (half == 0) {
            if (nsa && IN(pb + 1)) { MKCTX();
                gates_finalize(F, ws, s);
                for (int rp = 0; rp < REPN(3); ++rp) { if (EN(3)) for (int u = F.vcu; u < 32 * F.NBS; u += F.G) compress_unit(F, ws, j, u); }
                SEAM(pb + 1);
            }
            if (nsa && IN(pb + 2)) { MKCTX(); for (int rp = 0; rp < REPN(4); ++rp) { if (EN(4)) cmpattn_phase(F, ws); } SEAM(pb + 2); }
            if (IN(pb + 3)) { MKCTX(); for (int rp = 0; rp < REPN(5); ++rp) { if (EN(5)) flash_phase(F, ws, nsa); __syncthreads(); } SEAM(pb + 3); }
            if (IN(pb + 4) && !(MK_FUSEC && nsa)) { MKCTX(); for (int rp = 0; rp < REPN(6); ++rp) { if (EN(6)) { if (nsa) nsa_combine(F, ws); else diff_combine(F, ws, j, layer); } } SEAM(pb + 4); }
        }
        if (IN(pb + 5)) { MKCTX();
            const int rn = F.MS / nhf, r0 = F.m0 + hf * rn, hrow0 = nhf == 2 ? (F.m0 >> 1) : r0;
            pg8::Gemm g;
            g.M = rn; g.N = DM;
            if (half == 0) { g.A = (const bf16*)(ws + WS_AO) + (size_t)r0 * DM; g.K = DM; g.ld = DM; g.Bt = (nsa ? (const bf16*)(ws + WS_NWOUT) : (const bf16*)(ws + WS_DWOUT)) + (size_t)j * DM * DM; }
            else { g.A = (const bf16*)(ws + WS_HID) + (size_t)hrow0 * DFF; g.K = DFF; g.ld = DFF; g.Bt = (const bf16*)(ws + WS_W2T) + (size_t)layer * DM * DFF; }
            pg8::StaticOrder S; S.init(g.M, g.N, F.G, F.bid);
            STAGGER(MK_STAG5);
#define RUN_RESID(FIRST_, EMIT_) do { pg8::EpiResidT<FIRST_, EMIT_> E; E.ws = ws; E.xo = args.out; E.xo2 = args.out; E.lds = F.lds; E.s = s; E.m0 = r0; E.b0 = F.b0; \
                for (int rp = 0; rp < REPN(7); ++rp) { pg8::EpiResidT<FIRST_, EMIT_> E2 = E; if (rp + 1 < REPN(7)) E2.xo2 = (float*)(ws + WS_O0);     \
                    if (MK_NULLEPI && rp + 1 < REPN(7)) { pg8::EpiNull E0; pg8::gemm_phase<pg8::EpiNull, pg8::StaticOrder, true, true>(F.lds, g, S, E0, F.wave); }     \
                    else if (EN(7)) pg8::gemm_phase<pg8::EpiResidT<FIRST_, EMIT_>, pg8::StaticOrder, true, MK_SP2B>(F.lds, g, S, E2, F.wave); \
                    __syncthreads(); } } while (0)
            if (s == 0) RUN_RESID(true, true); else if (s == 7) RUN_RESID(false, false); else RUN_RESID(false, true);
#undef RUN_RESID
            SEAM(pb + 5);
        }
        }
    }
    if (MK_IDLEPROBE) { gu32* acc_ = (gu32*)(ws + WS_CTL) + 24576; if (opaque_tid(wv0) == 0) __hip_atomic_fetch_add(acc_, ((volatile LAS unsigned*)((LAS unsigned char*)lds + MISC_OFF))[16], RLX_AGENT);
        GRID_SYNC();
        if (blockIdx.x == 0 && opaque_tid(wv0) == 0) { const float us = (float)__hip_atomic_load(acc_, RLX_AGENT) * 0.01f / (float)gridDim.x; args.out[0] += 0.1f + us * (1.0f / 5000.0f); } }
#undef IN
#undef SEAM
}

static bool phase_exists(int k) {
    if (k < PH_STEP0) return true;
    const int s = (k - PH_STEP0) / PH_PER_STEP, slot = (k - PH_STEP0) % PH_PER_STEP, layer = s >> 1, half = s & 1;
    (void)s;
    if (slot == 0 || slot == 5) return true;
    if (half == 1) return false;
    if (slot == 1 || slot == 2) return (layer & 1) == 0;
    if (slot == 4) return !(MK_FUSEC && (layer & 1) == 0);
    return true;
}

extern "C" void kernel_launch(void* const* d_in, const int* in_sizes, int n_in, void* d_out, int out_size, void* d_ws, size_t ws_size, hipStream_t stream) {
    static int grid = 0;
    if (grid == 0) {
        if (n_in != 22 || in_sizes[0] != M * DM || out_size != M * DM || ws_size < WS_END) { fprintf(stderr, "kernel_launch: unexpected shapes (n_in %d, in0 %d, out %d, ws %zu; need ws >= %zu); nothing launched\n", n_in, n_in > 0 ? in_sizes[0] : -1, out_size, ws_size, (size_t)WS_END); grid = -1; return; }
        int dev = 0, cus = 0, per_cu = 0;
        if (hipGetDevice(&dev) != hipSuccess || hipDeviceGetAttribute(&cus, hipDeviceAttributeMultiprocessorCount, dev) != hipSuccess) { fprintf(stderr, "kernel_launch: device query failed\n"); grid = -1; return; }
        if (hipFuncSetAttribute((const void*)mk_fwd, hipFuncAttributeMaxDynamicSharedMemorySize, LDS_BYTES) != hipSuccess) { fprintf(stderr, "kernel_launch: hipFuncSetAttribute failed\n"); grid = -1; return; }
        if (hipOccupancyMaxActiveBlocksPerMultiprocessor(&per_cu, (const void*)mk_fwd, NWAVES * 64, LDS_BYTES) != hipSuccess || per_cu < 1)
            fprintf(stderr, "kernel_launch: note: occupancy query reports %d workgroups per CU\n", per_cu);
        (void)hipGetLastError();
        grid = cus;
    }
    if (grid < 0) return;
    if (hipMemsetAsync((char*)d_ws + WS_CTL, 0, CTL_ZERO_BYTES, stream) != hipSuccess) { fprintf(stderr, "kernel_launch: memset failed\n"); return; }
    Args a{};
    for (int i = 0; i < 22; ++i) a.in[i] = (const float*)d_in[i];
    a.out = (float*)d_out; a.ws = (unsigned char*)d_ws;
#if MK_N_LAUNCHES == 1
    a.ph_lo = 0; a.ph_hi = NPH;
    hipLaunchKernelGGL(mk_fwd, dim3(grid), dim3(NWAVES * 64), LDS_BYTES, stream, a);
#else
    for (int k = 0; k < NPH; ++k) { if (!phase_exists(k)) continue; a.ph_lo = k; a.ph_hi = k + 1;
        hipLaunchKernelGGL(mk_fwd, dim3(grid), dim3(NWAVES * 64), LDS_BYTES, stream, a); }
#endif
    const hipError_t le = hipPeekAtLastError();
    if (le != hipSuccess) fprintf(stderr, "kernel_launch: launch failed: %s\n", hipGetErrorName(le));
}
```

```cpp
#include <hip/hip_runtime.h>
#include <cstdio>
#include <cstdint>
#ifndef MK_N_LAUNCHES
#define MK_N_LAUNCHES 1
#endif
#ifndef MK_NOSEL
#define MK_NOSEL 0
#endif
#ifndef MK_SP2A
#define MK_SP2A true
#endif
#ifndef MK_SP2B
#define MK_SP2B true
#endif
#ifndef MK_WINPROBE
#define MK_WINPROBE 0
#endif
#ifndef MK_CMPPROBE
#define MK_CMPPROBE 0
#endif
#ifndef MK_XBF16
#define MK_XBF16 1
#endif
#ifndef MK_HSPLIT
#define MK_HSPLIT 0
#endif
#ifndef MK_DUAL
#define MK_DUAL 1
#endif
#ifndef MK_DIS
#define MK_DIS 0
#endif
#ifndef MK_REP
#define MK_REP 0
#endif
#ifndef MK_NULLEPI
#define MK_NULLEPI 0
#endif
#ifndef MK_FUSEC
#define MK_FUSEC 1
#endif
#ifndef MK_WIDE
#define MK_WIDE 0
#endif
#ifndef MK_NTS
#define MK_NTS 0
#endif
#define ST16(p, v) do { if (MK_NTS) __builtin_nontemporal_store((v), (u32x4*)(p)); else *(u32x4*)(p) = (v); } while (0)
#ifndef MK_REPC
#define MK_REPC 2
#endif
#define REPN(bit) (((MK_REP >> (bit)) & 1) ? MK_REPC : 1)
#define EN(bit) (!((MK_DIS >> (bit)) & 1))

constexpr int DM = 2048, NB = 8, T = 2048, M = NB * T, DFF = 8192;
constexpr int NSA_IN = 5168, NSA_INP = 5376, DIFF_IN = 6144, MODW = 6 * DM;
constexpr float EPS = 1e-6f;
constexpr int NWAVES = 8;

constexpr size_t MiB = 1u << 20;
constexpr size_t WS_CTL = 0, CTL_ZERO_BYTES = 256 * 1024;
constexpr size_t WS_MODP = 1 * MiB;
constexpr size_t WS_MOD = 13 * MiB;
constexpr size_t WS_ROPE = 15 * MiB;
constexpr size_t WS_GATES = 23 * MiB;
constexpr size_t WS_GS = 1120 * MiB;
constexpr size_t WS_SSQ = 1121 * MiB;
constexpr size_t WS_SHW = 1122 * MiB;
constexpr size_t WS_SEL = 1444 * MiB;
constexpr size_t WS_KCMP = 27 * MiB;
constexpr size_t WS_VCMP = 28 * MiB;
constexpr size_t WS_CW2 = 29 * MiB;
constexpr size_t WS_CW1 = 30 * MiB;
constexpr size_t WS_W1T = 38 * MiB;
constexpr size_t WS_W2T = 166 * MiB;
constexpr size_t WS_NWIN = 294 * MiB;
constexpr size_t WS_NWOUT = 336 * MiB;
constexpr size_t WS_DWIN = 352 * MiB;
constexpr size_t WS_DWOUT = 400 * MiB;
constexpr size_t WS_H = 416 * MiB;
constexpr size_t WS_AO = 480 * MiB;
constexpr size_t WS_RAW = 544 * MiB;
constexpr size_t WS_QHM = 736 * MiB;
constexpr size_t WS_HID = 1124 * MiB;
constexpr size_t WS_KA = 800 * MiB;
constexpr size_t WS_VA = 864 * MiB;
constexpr size_t WS_O0 = 928 * MiB;
constexpr size_t WS_XB = 1380 * MiB;
constexpr size_t WS_GP = 1445 * MiB;
constexpr size_t WS_END = 1458 * MiB;

constexpr int CW_BAR = 4096;
constexpr int CW_WFLAG = 16384;

constexpr int LDS_RL = 131072, LDS_SL = 133120;
constexpr int LDSCTL_OFF = 143360, PTR_OFF = LDSCTL_OFF + 64, MISC_OFF = LDSCTL_OFF + 320, LDS_BYTES = 147456;

__device__ __forceinline__ const float* in_ptr(__attribute__((address_space(3))) unsigned char* lds, int k) { const __attribute__((address_space(3))) unsigned* p = (const __attribute__((address_space(3))) unsigned*)(lds + PTR_OFF) + 2 * k;
    const unsigned lo = __builtin_amdgcn_readfirstlane(p[0]), hi = __builtin_amdgcn_readfirstlane(p[1]); return (const float*)(((unsigned long long)hi << 32) | lo); }
__device__ __forceinline__ int opaque_tid(int wv) { unsigned m = ~0u; asm volatile("" : "+s"(m), "+s"(wv)); return wv * 64 + (int)__builtin_amdgcn_mbcnt_hi(m, __builtin_amdgcn_mbcnt_lo(m, 0u)); }
__device__ __forceinline__ int opaque_bid() { int b = blockIdx.x; asm volatile("" : "+s"(b)); return b; }
namespace pg8 {
#define PG8_LAS __attribute__((address_space(3)))
typedef unsigned short bf16_t;
typedef short bf16x8 __attribute__((ext_vector_type(8)));
typedef float f32x4 __attribute__((ext_vector_type(4)));
typedef unsigned u32x4 __attribute__((ext_vector_type(4)));
constexpr int BM = 256, BK = 64, HALF = 128, HTB = HALF * BK * 2  , STAGE_BYTES = 8 * HTB, NXCD = 8, WGM = 8;

__host__ __device__ __forceinline__ int lds_byte(int r, int c) { const int st = (r >> 4) * 2 + (c >> 5), rr = r & 15, cc = c & 31, ob = rr * 64 + cc * 2; return st * 1024 + (ob ^ (((ob >> 9) & 1) << 5)); }
__host__ __device__ __forceinline__ void stage_rc(int b, int& R, int& C) { const int st = b / 1024, sb = b % 1024, swz = sb ^ (((sb >> 9) & 1) << 5); R = (st >> 1) * 16 + swz / 64; C = (st & 1) * 32 + (swz % 64) / 2; }
__host__ __device__ __forceinline__ int perm32(int rho) { const int n = rho >> 4, i = rho & 15; return 8 * (i >> 2) + 4 * n + (i & 3); }

struct Unit { int pm, pn, ko; };
struct Gemm { const bf16_t* A; const bf16_t* Bt; int M, N, K, ld; };

struct StaticOrder {
    int nM, nN, nwg, G, c;
    __host__ __device__ void init(int M, int N, int G_, int c_) { nM = M / BM; nN = N / BM; nwg = nM * nN; G = G_; c = c_; }
    __host__ __device__ bool next(int i, Unit& u) const {
        const long L = (long)i * G + c; if (L >= nwg) return false;
        int wgid = (int)L; { const int q = nwg / NXCD, r = nwg % NXCD, xcd = wgid % NXCD, off = wgid / NXCD; wgid = (xcd < r ? xcd * (q + 1) : r * (q + 1) + (xcd - r) * q) + off; }
        const int nig = WGM * nN, gid = wgid / nig, fm = gid * WGM, gsz = (nM - fm) < WGM ? (nM - fm) : WGM;
        u.pm = fm + ((wgid % nig) % gsz); u.pn = (wgid % nig) / gsz; u.ko = 0; return true;
    }
    __device__ __forceinline__ void a_ready(const Unit&) const {}
    __device__ __forceinline__ void done(const Unit&) const {}
};
struct SplitKOrder {
    int nU, G, c, pn, kq;
    __host__ __device__ void init(int M, int pn_, int kq_, int G_, int c_) { nU = (M / BM) * 4; pn = pn_; kq = kq_; G = G_; c = c_; }
    __host__ __device__ bool next(int i, Unit& u) const { const int L = i * G + c; if (L >= nU) return false; u.pm = L >> 2; u.pn = pn; u.ko = (L & 3) * kq; return true; }
    __device__ __forceinline__ void a_ready(const Unit&) const {}
    __device__ __forceinline__ void done(const Unit&) const {}
};
__device__ __forceinline__ unsigned cvt_pk_bf16(float lo, float hi) { unsigned r; asm volatile("v_cvt_pk_bf16_f32 %0, %1, %2" : "=v"(r) : "v"(lo), "v"(hi)); return r; }
typedef float f32x2 __attribute__((ext_vector_type(2)));
typedef _Float16 f16x2_t __attribute__((ext_vector_type(2)));
__device__ __forceinline__ unsigned cvt_pk_f16(float lo, float hi) { f16x2_t h; h.x = (_Float16)lo; h.y = (_Float16)hi; return __builtin_bit_cast(unsigned, h); }
__device__ __forceinline__ float f16lo(unsigned w) { return (float)__builtin_bit_cast(f16x2_t, w).x; }
__device__ __forceinline__ float f16hi(unsigned w) { return (float)__builtin_bit_cast(f16x2_t, w).y; }
struct EpiPre { f32x4 sq; float bias; };
__device__ __forceinline__ void epi_prefetch(EpiPre& p, const unsigned char* ws, int site, int m0, int b0, const Unit& u, int tid) {
    p.sq = *(const f32x4*)((const float*)(ws + WS_SSQ) + (size_t)(m0 + u.pm * BM + (tid >> 1)) * 8 + 4 * (tid & 1));
    p.bias = ((const float*)(ws + WS_SHW))[((size_t)site * NB + ((m0 + u.pm * BM) >> 11)) * 8192 + u.pn * BM + (tid & 255)];
}
__device__ __forceinline__ void epi_rowstats(const EpiPre& p, PG8_LAS float* rl, int tid) {
    float s = (p.sq.x + p.sq.y) + (p.sq.z + p.sq.w); s += __shfl_xor(s, 1);
    if ((tid & 1) == 0) rl[tid >> 1] = 1.0f / sqrtf(s * (1.0f / 2048.0f) + 1e-6f);
    if (tid < 256) rl[256 + tid] = p.bias;
    asm volatile("s_waitcnt lgkmcnt(0)" ::: "memory"); __builtin_amdgcn_s_barrier(); asm volatile("" ::: "memory");
}
struct EpiStore {
    static constexpr bool PERM = true, AFTER_DRAIN = false, WIDE = MK_WIDE != 0;
    unsigned char* ws; PG8_LAS unsigned char* lds; int site, m0, b0, hrow0;
    typedef EpiPre Pre;
    __device__ __forceinline__ void prefetch(Pre& p, const Unit& u, int tid) const { epi_prefetch(p, ws, site, m0, b0, u, tid); }
    __device__ __forceinline__ void operator()(const f32x4 (&acc)[2][2][4][2], const Unit& u, int wr, int wc, int fr, int fq, const Pre& p) const {
        asm volatile("" : "+v"(fr), "+v"(fq), "+s"(wr), "+s"(wc));
        PG8_LAS float* rl = (PG8_LAS float*)(lds + LDS_RL);
        epi_rowstats(p, rl, (wr * 4 + wc) * 64 + fq * 16 + fr);
        bf16_t* O = (bf16_t*)(ws + WS_HID);
        f32x4 bv[2][2];
        if constexpr (WIDE) {
            const int colw = wc * 64 + 8 * fq;
#pragma unroll
            for (int bj = 0; bj < 2; ++bj)
#pragma unroll
                for (int n = 0; n < 2; ++n) bv[bj][n] = *(const PG8_LAS f32x4*)(rl + 256 + colw + bj * 32 + 4 * n);
            const int hiF = fr >> 3, fr7 = fr & 7;
            bf16_t* base = O + (size_t)(hrow0 + u.pm * BM + wr * 64 + fr7) * DFF + u.pn * BM + wc * 64 + hiF * 32 + 8 * fq;
#pragma unroll
            for (int ai = 0; ai < 2; ++ai)
#pragma unroll
                for (int m = 0; m < 4; ++m) { const float rs = rl[ai * HALF + wr * 64 + m * 16 + fr]; u32x4 w[2];
#pragma unroll
                    for (int bj = 0; bj < 2; ++bj) { f32x4 v0 = acc[ai][bj][m][0] * rs + bv[bj][0], v1 = acc[ai][bj][m][1] * rs + bv[bj][1];
                        v0 = __builtin_elementwise_max(v0, (f32x4){0.f, 0.f, 0.f, 0.f}); v1 = __builtin_elementwise_max(v1, (f32x4){0.f, 0.f, 0.f, 0.f}); v0 = v0 * v0; v1 = v1 * v1;
                        w[bj].x = cvt_pk_bf16(v0[0], v0[1]); w[bj].y = cvt_pk_bf16(v0[2], v0[3]); w[bj].z = cvt_pk_bf16(v1[0], v1[1]); w[bj].w = cvt_pk_bf16(v1[2], v1[3]); }
                    u32x4 snd, rcv;
#pragma unroll
                    for (int e = 0; e < 4; ++e) { snd[e] = hiF ? w[0][e] : w[1][e]; rcv[e] = (unsigned)__builtin_amdgcn_update_dpp(0, (int)snd[e], 0x128, 0xf, 0xf, false); }
                    bf16_t* rowp = base + (size_t)(ai * HALF + m * 16) * DFF;
                    { const u32x4 sa_ = hiF ? rcv : w[0]; ST16(rowp, sa_); }
                    { const u32x4 sb_ = hiF ? w[1] : rcv; ST16(rowp + (size_t)8 * DFF, sb_); } }
        } else {
        const int row0 = hrow0 + u.pm * BM + wr * 64 + fr, col0 = u.pn * BM + wc * 32 + 8 * fq;
#pragma unroll
        for (int bj = 0; bj < 2; ++bj)
#pragma unroll
            for (int n = 0; n < 2; ++n) bv[bj][n] = *(const PG8_LAS f32x4*)(rl + 256 + wc * 32 + 8 * fq + bj * HALF + 4 * n);
#pragma unroll
        for (int ai = 0; ai < 2; ++ai)
#pragma unroll
            for (int m = 0; m < 4; ++m) { bf16_t* rowp = O + (size_t)(row0 + ai * HALF + m * 16) * DFF + col0; const float rs = rl[ai * HALF + wr * 64 + m * 16 + fr];
#pragma unroll
                for (int bj = 0; bj < 2; ++bj) { f32x4 v0 = acc[ai][bj][m][0] * rs + bv[bj][0], v1 = acc[ai][bj][m][1] * rs + bv[bj][1];
                    v0 = __builtin_elementwise_max(v0, (f32x4){0.f, 0.f, 0.f, 0.f}); v1 = __builtin_elementwise_max(v1, (f32x4){0.f, 0.f, 0.f, 0.f}); v0 = v0 * v0; v1 = v1 * v1;
                    u32x4 w; w.x = cvt_pk_bf16(v0[0], v0[1]); w.y = cvt_pk_bf16(v0[2], v0[3]); w.z = cvt_pk_bf16(v1[0], v1[1]); w.w = cvt_pk_bf16(v1[2], v1[3]);
                    ST16(rowp + bj * HALF, w); } }
        }
    }
};
struct EpiQKV {
    static constexpr bool PERM = true, AFTER_DRAIN = false, WIDE = false;
    unsigned char* ws; PG8_LAS unsigned char* lds; int site, j, nsa, m0, b0;
    typedef EpiPre Pre;
    __device__ __forceinline__ void prefetch(Pre& p, const Unit& u, int tid) const { epi_prefetch(p, ws, site, m0, b0, u, tid); }
    __device__ __forceinline__ void operator()(const f32x4 (&acc)[2][2][4][2], const Unit& u, int wr, int wc, int fr, int fq, const Pre& p) const {
        asm volatile("" : "+v"(fr), "+v"(fq), "+s"(wr), "+s"(wc));
        typedef unsigned u32x2_t __attribute__((ext_vector_type(2)));
        PG8_LAS float* rl = (PG8_LAS float*)(lds + LDS_RL); PG8_LAS float* nl = (PG8_LAS float*)(lds + LDS_SL);
        epi_rowstats(p, rl, (wr * 4 + wc) * 64 + fq * 16 + fr);
        bf16_t* raw = (bf16_t*)(ws + WS_RAW); bf16_t* qhm = (bf16_t*)(ws + WS_QHM); bf16_t* ka = (bf16_t*)(ws + WS_KA); bf16_t* va = (bf16_t*)(ws + WS_VA);
        const unsigned* rope = (const unsigned*)(ws + WS_ROPE); float* gates = (float*)(ws + WS_GATES); const int ldc = nsa ? NSA_INP : DIFF_IN;
        const float* g_q = in_ptr(lds, nsa ? 11 : 18) + j * 128;
        const float* g_k1 = nsa ? in_ptr(lds, 12) + j * 384 + 128 : in_ptr(lds, 19) + j * 128;
        const float* g_k2 = nsa ? in_ptr(lds, 12) + j * 384 + 256 : g_k1;
        const int pn = u.pn; int mode, nh, hidx0; bf16_t* dst; const float* gamma;
        if (pn < 8) { mode = 1; nh = 16; hidx0 = 2 * pn; dst = qhm; gamma = g_q; }
        else if (nsa) {
            if (pn < 12) { mode = 0; nh = 0; hidx0 = 0; dst = raw; gamma = g_q; }
            else if (pn < 20) { const int w4 = (pn - 12) >> 1;
                mode = (w4 & 1) ? 2 : 1; nh = 4; hidx0 = 2 * ((pn - 12) & 1); dst = ka + (size_t)((w4 >> 1) + 2 * (w4 & 1)) * 8388608; gamma = (w4 >> 1) ? g_k2 : g_k1; }
            else { mode = 3; nh = 0; hidx0 = 0; dst = raw; gamma = g_q; }
        } else {
            if (pn < 16) { mode = 1; nh = 16; hidx0 = 2 * (pn - 8); dst = ka; gamma = g_k1; }
            else { mode = 2; nh = 16; hidx0 = 2 * (pn - 16); dst = va; gamma = g_q; }
        }
        const int rbase = m0 + u.pm * BM + wr * 64 + fr;
        f32x4 bv[2][2];
#pragma unroll
        for (int bj = 0; bj < 2; ++bj)
#pragma unroll
            for (int n = 0; n < 2; ++n) bv[bj][n] = *(const PG8_LAS f32x4*)(rl + 256 + wc * 32 + 8 * fq + bj * HALF + 4 * n);
        if (mode == 1) {
            const int Q = 4 * wc + fq;
            u32x4 ra[2], rb[2];
#define RC_LOAD(X, i) do { _Pragma("unroll") for (int mm = 0; mm < 2; ++mm) X[mm] = *(const u32x4*)(rope + (size_t)(rbase + ((i) >> 1) * HALF + (((i) & 1) * 2 + mm) * 16) * 64 + 4 * Q); } while (0)
            RC_LOAD(ra, 0);
#pragma unroll
            for (int ai = 0; ai < 2; ++ai)
#pragma unroll
                for (int m = 0; m < 4; ++m) { const int rloc = ai * HALF + wr * 64 + m * 16 + fr; const float rs = rl[rloc];
#pragma unroll
                    for (int bj = 0; bj < 2; ++bj) { const f32x4 a = acc[ai][bj][m][0] * rs + bv[bj][0], b = acc[ai][bj][m][1] * rs + bv[bj][1];
                        float q = (a[0] * a[0] + a[1] * a[1]) + (a[2] * a[2] + a[3] * a[3]) + (b[0] * b[0] + b[1] * b[1]) + (b[2] * b[2] + b[3] * b[3]);
                        q += __shfl_xor(q, 16); q += __shfl_xor(q, 32); if (fq == 0) nl[(rloc * 2 + bj) * 4 + wc] = q; } }
            asm volatile("s_waitcnt lgkmcnt(0)" ::: "memory"); __builtin_amdgcn_s_barrier(); asm volatile("" ::: "memory");
            const f32x4 g1 = *(const f32x4*)(gamma + 4 * Q), g2 = *(const f32x4*)(gamma + 64 + 4 * Q);
#define RC_DO(X, i) do { _Pragma("unroll") for (int mm = 0; mm < 2; ++mm) { const int ai = (i) >> 1, m = ((i) & 1) * 2 + mm, rloc = ai * HALF + wr * 64 + m * 16 + fr, row = rbase + ai * HALF + m * 16, b = row >> 11, t = row & 2047; const float rs = rl[rloc]; \
                const u32x4 cw = X[mm]; const f32x4 co = {f16lo(cw.x), f16lo(cw.y), f16lo(cw.z), f16lo(cw.w)}, si = {f16hi(cw.x), f16hi(cw.y), f16hi(cw.z), f16hi(cw.w)};     \
                _Pragma("unroll") for (int bj = 0; bj < 2; ++bj) { const f32x4 sq4 = *(const PG8_LAS f32x4*)(nl + (rloc * 2 + bj) * 4); \
                    const float rh = 1.0f / sqrtf(((sq4.x + sq4.y) + (sq4.z + sq4.w)) * (1.0f / 128.0f) + 1e-6f); \
                    const f32x4 y1 = (acc[ai][bj][m][0] * rs + bv[bj][0]) * rh * g1, y2 = (acc[ai][bj][m][1] * rs + bv[bj][1]) * rh * g2; \
                    const f32x4 o1 = y1 * co - y2 * si, o2 = y2 * co + y1 * si; \
                    bf16_t* dp = dst + ((size_t)(b * nh + hidx0 + bj) * 2048 + t) * 128 + ((fq & 1) ? 64 + 4 * (Q - 1) : 4 * Q); \
                    u32x2_t w1, w2; w1.x = cvt_pk_bf16(o1[0], o1[1]); w1.y = cvt_pk_bf16(o1[2], o1[3]); w2.x = cvt_pk_bf16(o2[0], o2[1]); w2.y = cvt_pk_bf16(o2[2], o2[3]); \
                    const auto sx_ = __builtin_amdgcn_permlane16_swap(w1.x, w2.x, false, false); const auto sy_ = __builtin_amdgcn_permlane16_swap(w1.y, w2.y, false, false);     \
                    u32x4 q4_; q4_.x = sx_[0]; q4_.y = sy_[0]; q4_.z = sx_[1]; q4_.w = sy_[1]; *(u32x4*)dp = q4_; } } } while (0)
#define RC_FENCE() asm volatile("" ::: "memory")
            RC_LOAD(rb, 1); RC_FENCE(); RC_DO(ra, 0); RC_FENCE();
            RC_LOAD(ra, 2); RC_FENCE(); RC_DO(rb, 1); RC_FENCE();
            RC_LOAD(rb, 3); RC_FENCE(); RC_DO(ra, 2); RC_FENCE();
            RC_DO(rb, 3);
#undef RC_LOAD
#undef RC_DO
#undef RC_FENCE
        } else {
#pragma unroll
            for (int ai = 0; ai < 2; ++ai)
#pragma unroll
                for (int m = 0; m < 4; ++m) { const int rloc = ai * HALF + wr * 64 + m * 16 + fr, row = rbase + ai * HALF + m * 16, b = row >> 11, t = row & 2047; const float rs = rl[rloc];
#pragma unroll
                    for (int bj = 0; bj < 2; ++bj) { const f32x4 v0 = acc[ai][bj][m][0] * rs + bv[bj][0], v1 = acc[ai][bj][m][1] * rs + bv[bj][1];
                        if (mode == 3) { const int c0 = bj * HALF + wc * 32 + 8 * fq;
                            if (c0 < 48) { f32x4 s0, s1;
#pragma unroll
                                for (int i = 0; i < 4; ++i) { s0[i] = 1.0f / (1.0f + __expf(-v0[i])); s1[i] = 1.0f / (1.0f + __expf(-v1[i])); }
#pragma unroll
                                for (int i = 0; i < 4; ++i) { const int ca = c0 + i, cb = c0 + 4 + i;
                                    gates[((size_t)row * 16 + (ca & 15)) * 4 + (ca >> 4)] = s0[i]; gates[((size_t)row * 16 + (cb & 15)) * 4 + (cb >> 4)] = s1[i]; } } }
                        else { u32x4 w; w.x = cvt_pk_bf16(v0[0], v0[1]); w.y = cvt_pk_bf16(v0[2], v0[3]); w.z = cvt_pk_bf16(v1[0], v1[1]); w.w = cvt_pk_bf16(v1[2], v1[3]);
                            bf16_t* dp = mode == 0 ? raw + (size_t)row * ldc + pn * BM + bj * HALF + wc * 32 + 8 * fq
                                                   : dst + ((size_t)(b * nh + hidx0 + bj) * 2048 + t) * 128 + wc * 32 + 8 * fq;
                            *(u32x4*)dp = w; } } }
        }
    }
};
struct EpiGatesP {
    static constexpr bool PERM = true, AFTER_DRAIN = false, WIDE = false;
    unsigned char* ws; int m0;
    struct Pre {};
    __device__ __forceinline__ void prefetch(Pre&, const Unit&, int) const {}
    __device__ __forceinline__ void operator()(const f32x4 (&acc)[2][2][4][2], const Unit& u, int wr, int wc, int fr, int fq, const Pre&) const {
        asm volatile("" : "+v"(fr), "+v"(fq), "+s"(wr), "+s"(wc));
        float* gp = (float*)(ws + WS_GP) + (size_t)(u.ko >> 9) * ((size_t)M * 48);
        const int c0 = wc * 32 + 8 * fq;
        if (c0 < 48) {
#pragma unroll
            for (int ai = 0; ai < 2; ++ai)
#pragma unroll
                for (int m = 0; m < 4; ++m) { float* rp_ = gp + (size_t)(m0 + u.pm * BM + ai * HALF + wr * 64 + m * 16 + fr) * 48 + c0;
                    *(f32x4*)rp_ = acc[ai][0][m][0]; *(f32x4*)(rp_ + 4) = acc[ai][0][m][1]; }
        }
    }
};
struct EpiNull { static constexpr bool PERM = true, AFTER_DRAIN = false, WIDE = false; struct Pre {}; __device__ __forceinline__ void prefetch(Pre&, const Unit&, int) const {}
    __device__ __forceinline__ void operator()(const f32x4 (&acc)[2][2][4][2], const Unit&, int, int, int, int, const Pre&) const {
#pragma unroll
        for (int a = 0; a < 2; ++a)
#pragma unroll
            for (int b = 0; b < 2; ++b)
#pragma unroll
                for (int m = 0; m < 4; ++m)
#pragma unroll
                    for (int n = 0; n < 2; ++n) asm volatile("" :: "v"(acc[a][b][m][n]));
    } };
template <bool FIRST_, bool EMIT_>
struct EpiResidT {
    static constexpr bool PERM = false, AFTER_DRAIN = false, WIDE = false;
    unsigned char* ws; float* xo; float* xo2; PG8_LAS unsigned char* lds; int s, m0, b0;
    struct Pre {};
    __device__ __forceinline__ void prefetch(Pre&, const Unit&, int) const {}
    __device__ __forceinline__ void operator()(const f32x4 (&acc)[2][2][4][2], const Unit& u, int wr, int wc, int fr, int fq, const Pre&) const {
        asm volatile("" : "+v"(fr), "+v"(fq), "+s"(wr), "+s"(wc));
        constexpr bool emit = EMIT_, first = FIRST_;
        const int layer = s >> 1, bat = (m0 + u.pm * BM) >> 11;
        bf16_t* xcar = (bf16_t*)(ws + WS_XB) + (size_t)m0 * 2048;
        const float* xin = (s == 0 ? in_ptr(lds, 0) : xo) + (size_t)m0 * 2048; float* xout = xo2 + (size_t)m0 * 2048; bf16_t* xg = (bf16_t*)(ws + WS_H) + (size_t)m0 * 2048;
        const float* gp = (const float*)(ws + WS_MOD) + ((size_t)layer * NB + bat) * MODW + ((s & 1) ? 5 : 2) * 2048;
        const float* gs = (const float*)(ws + WS_GS) + ((size_t)(s + 1) * NB + bat) * 2048;
        float* ssq = (float*)(ws + WS_SSQ) + (size_t)m0 * 8; PG8_LAS float* sl = (PG8_LAS float*)(lds + LDS_SL);
        const int col0 = u.pn * BM + wc * 32 + 4 * fq;
        f32x4 gv[2][2], sv[2][2];
#pragma unroll
        for (int bj = 0; bj < 2; ++bj)
#pragma unroll
            for (int n = 0; n < 2; ++n) { gv[bj][n] = *(const f32x4*)(gp + col0 + bj * HALF + n * 16); sv[bj][n] = emit ? *(const f32x4*)(gs + col0 + bj * HALF + n * 16) : (f32x4){0.f, 0.f, 0.f, 0.f}; }
        const int hiF = fr >> 3, fr7 = fr & 7;
        const size_t offx = (size_t)(u.pm * BM + wr * 64 + fr7) * 2048 + u.pn * BM + wc * 32 + 16 * hiF + 4 * fq;
        typedef unsigned u32x2_t __attribute__((ext_vector_type(2)));
        const size_t og_ = (size_t)(u.pm * BM + wr * 64 + fr7 + 8 * (fq & 1)) * 2048 + u.pn * BM + wc * 32 + 16 * hiF + 4 * (fq & ~1);
#define ROR8(x) __uint_as_float((unsigned)__builtin_amdgcn_update_dpp(0, (int)__float_as_uint(x), 0x128, 0xf, 0xf, false))
#define ROR8U(x) ((unsigned)__builtin_amdgcn_update_dpp(0, (int)(x), 0x128, 0xf, 0xf, false))
        f32x4 xa[2][2], xb[2][2], xc[2][2];
        bf16_t* xcf = xcar + (size_t)(u.pm * 8 + u.pn) * 65536 + (size_t)(((wr * 4 + wc) * 64 + fq * 16 + fr) * 8);
#define RES_LOAD(X, i) do { const size_t r_ = (size_t)(((i) >> 2) * HALF + ((i) & 3) * 16) * 2048, o_ = offx + r_; _Pragma("unroll") for (int bj = 0; bj < 2; ++bj) { \
        if (MK_XBF16 && !first) { X[bj][0] = __builtin_bit_cast(f32x4, *(const u32x4*)(xcf + ((i) * 2 + bj) * 4096)); }     \
        else { X[bj][0] = *(const f32x4*)(xin + o_ + bj * HALF); X[bj][1] = *(const f32x4*)(xin + o_ + bj * HALF + 8 * 2048); } } } while (0)
#define RES_DO(X, i) do { const int ai = (i) >> 2, m = (i) & 3, rloc = ai * HALF + wr * 64 + m * 16 + fr; const size_t o_ = offx + (size_t)(ai * HALF + m * 16) * 2048; float q = 0.f; \
        _Pragma("unroll") for (int bj = 0; bj < 2; ++bj) { f32x4 snd, rcv; f32x4 x0, x1;                                                                     \
            if (MK_XBF16 && !first) { const u32x4 q_ = __builtin_bit_cast(u32x4, X[bj][0]); \
                x0 = (f32x4){f16lo(q_.x), f16hi(q_.x), f16lo(q_.y), f16hi(q_.y)}; x1 = (f32x4){f16lo(q_.z), f16hi(q_.z), f16lo(q_.w), f16hi(q_.w)}; } \
            else { const f32x4 v1 = X[bj][0], v2 = X[bj][1]; _Pragma("unroll") for (int e = 0; e < 4; ++e) { snd[e] = hiF ? v1[e] : v2[e]; rcv[e] = ROR8(snd[e]); } \
                _Pragma("unroll") for (int e = 0; e < 4; ++e) { x0[e] = hiF ? rcv[e] : v1[e]; x1[e] = hiF ? v2[e] : rcv[e]; } } \
            const f32x4 n0 = x0 + gv[bj][0] * acc[ai][bj][m][0], n1 = x1 + gv[bj][1] * acc[ai][bj][m][1]; \
            if (MK_XBF16 && emit) { u32x2_t c0, c1; c0.x = cvt_pk_f16(n0[0], n0[1]); c0.y = cvt_pk_f16(n0[2], n0[3]); c1.x = cvt_pk_f16(n1[0], n1[1]); c1.y = cvt_pk_f16(n1[2], n1[3]); \
                u32x4 c4_; c4_.x = c0.x; c4_.y = c0.y; c4_.z = c1.x; c4_.w = c1.y; *(u32x4*)(xcf + ((i) * 2 + bj) * 4096) = c4_; }     \
            else { _Pragma("unroll") for (int e = 0; e < 4; ++e) { snd[e] = hiF ? n0[e] : n1[e]; rcv[e] = ROR8(snd[e]); } \
            f32x4 s1, s2; _Pragma("unroll") for (int e = 0; e < 4; ++e) { s1[e] = hiF ? rcv[e] : n0[e]; s2[e] = hiF ? n1[e] : rcv[e]; } \
            *(f32x4*)(xout + o_ + bj * HALF) = s1; *(f32x4*)(xout + o_ + bj * HALF + 8 * 2048) = s2; } \
            if (emit) { const f32x4 y0 = n0 * sv[bj][0], y1 = n1 * sv[bj][1]; u32x2_t w0, w1; w0.x = cvt_pk_bf16(y0[0], y0[1]); w0.y = cvt_pk_bf16(y0[2], y0[3]); w1.x = cvt_pk_bf16(y1[0], y1[1]); w1.y = cvt_pk_bf16(y1[2], y1[3]); \
                u32x2_t ws_, wr_; ws_.x = hiF ? w0.x : w1.x; ws_.y = hiF ? w0.y : w1.y; wr_.x = ROR8U(ws_.x); wr_.y = ROR8U(ws_.y); \
                u32x2_t t1, t2; t1.x = hiF ? wr_.x : w0.x; t1.y = hiF ? wr_.y : w0.y; t2.x = hiF ? w1.x : wr_.x; t2.y = hiF ? w1.y : wr_.y;            \
                const auto sx_ = __builtin_amdgcn_permlane16_swap(t1.x, t2.x, false, false); const auto sy_ = __builtin_amdgcn_permlane16_swap(t1.y, t2.y, false, false);     \
                u32x4 q4_; q4_.x = sx_[0]; q4_.y = sy_[0]; q4_.z = sx_[1]; q4_.w = sy_[1]; *(u32x4*)(xg + og_ + (size_t)(ai * HALF + m * 16) * 2048 + bj * HALF) = q4_; \
                q += (n0[0] * n0[0] + n0[1] * n0[1]) + (n0[2] * n0[2] + n0[3] * n0[3]) + (n1[0] * n1[0] + n1[1] * n1[1]) + (n1[2] * n1[2] + n1[3] * n1[3]); } } \
        if (emit) { q += __shfl_xor(q, 16); q += __shfl_xor(q, 32); if (fq == 0) sl[rloc * 4 + wc] = q; } } while (0)
#define RES_FENCE() asm volatile("" ::: "memory")
        RES_LOAD(xa, 0); RES_LOAD(xb, 1); RES_FENCE();
        RES_LOAD(xc, 2); RES_FENCE(); RES_DO(xa, 0); RES_FENCE();
        RES_LOAD(xa, 3); RES_FENCE(); RES_DO(xb, 1); RES_FENCE();
        RES_LOAD(xb, 4); RES_FENCE(); RES_DO(xc, 2); RES_FENCE();
        RES_LOAD(xc, 5); RES_FENCE(); RES_DO(xa, 3); RES_FENCE();
        RES_LOAD(xa, 6); RES_FENCE(); RES_DO(xb, 4); RES_FENCE();
        RES_LOAD(xb, 7); RES_FENCE(); RES_DO(xc, 5); RES_FENCE();
        RES_DO(xa, 6); RES_FENCE(); RES_DO(xb, 7);
#undef RES_LOAD
#undef RES_DO
#undef RES_FENCE
#undef ROR8
#undef ROR8U
        if (emit) { asm volatile("s_waitcnt lgkmcnt(0)" ::: "memory"); __builtin_amdgcn_s_barrier(); asm volatile("" ::: "memory");
            const int tid = (wr * 4 + wc) * 64 + fq * 16 + fr;
            if (tid < 256) { const f32x4 p = *(const PG8_LAS f32x4*)(sl + tid * 4); ssq[(size_t)(u.pm * BM + tid) * 8 + u.pn] = (p.x + p.y) + (p.z + p.w); } }
    }
};
template <class Epi, class Sched, bool ALIGN_EPI = false, bool SP2 = false>
__device__ __forceinline__ void gemm_phase(PG8_LAS unsigned char* lds, const Gemm g, const Sched& S, const Epi& E, const int wv) {
    const int tid = opaque_tid(wv), wid = __builtin_amdgcn_readfirstlane(tid >> 6), lane = tid & 63, wr = wid >> 2, wc = wid & 3, fr = lane & 15, fq = lane >> 4;
    const int K = g.ld, nt = g.K / BK;
    unsigned voffA[2], voffB[2];
#pragma unroll
    for (int i = 0; i < 2; ++i) { int R, C; stage_rc(tid * 16 + i * 8192, R, C); const int Rb = Epi::WIDE ? ((R >> 5) * 64 + perm32(R & 31)) : (Epi::PERM ? ((R & ~31) + perm32(R & 31)) : R);
        voffA[i] = (unsigned)(R * K + C) * 2u; voffB[i] = (unsigned)(Rb * K + C) * 2u; }
    const size_t kstep = (size_t)(BK * 2);
    const size_t hstep = (size_t)HALF * K * 2;
    const size_t tstep = 2 * hstep;
    const size_t hstepB = Epi::WIDE ? (size_t)32 * K * 2 : hstep;
    const unsigned ldsw = (unsigned)wid * 1024u;
    const int aoff = lds_byte(wr * 64 + fr, fq * 8), boff = lds_byte(wc * 32 + fr, fq * 8);
#define PG8_SA(b, h) (((b) * 2 + (h)) * HTB)
#define PG8_SB(b, h) ((4 + (b) * 2 + (h)) * HTB)
#define PG8_STAGE(bufoff, gbase, voff) do { _Pragma("unroll") for (int _i = 0; _i < 2; ++_i) \
        __builtin_amdgcn_global_load_lds((const unsigned*)((const char*)(gbase) + (voff)[_i]), (PG8_LAS unsigned*)(lds + (bufoff) + ldsw + _i * 8192), 16, 0, 0); } while (0)
#define PG8_LDA(dst, b, h) do { _Pragma("unroll") for (int m = 0; m < 4; ++m) _Pragma("unroll") for (int k = 0; k < 2; ++k) dst[m][k] = *(const PG8_LAS bf16x8*)(lds + PG8_SA(b, h) + aoff + m * 2048 + k * 1024); } while (0)
#define PG8_LDB(dst, b, h) do { _Pragma("unroll") for (int n = 0; n < 2; ++n) _Pragma("unroll") for (int k = 0; k < 2; ++k) dst[n][k] = *(const PG8_LAS bf16x8*)(lds + PG8_SB(b, h) + boff + n * 2048 + k * 1024); } while (0)
#define PG8_MMA(ai, bj, At, Bt) do { __builtin_amdgcn_s_setprio(1); _Pragma("unroll") for (int m = 0; m < 4; ++m) _Pragma("unroll") for (int n = 0; n < 2; ++n) _Pragma("unroll") for (int k = 0; k < 2; ++k) \
        acc[ai][bj][m][n] = __builtin_amdgcn_mfma_f32_16x16x32_bf16(Bt[n][k], At[m][k], acc[ai][bj][m][n], 0, 0, 0); __builtin_amdgcn_s_setprio(0); } while (0)
#define PG8_WAIT_V(n) asm volatile("s_waitcnt vmcnt(" #n ")" ::: "memory")
#define PG8_WAIT_L(n) asm volatile("s_waitcnt lgkmcnt(" #n ")" ::: "memory")
#define PG8_BAR __builtin_amdgcn_s_barrier()
#define PG8_SCHED __builtin_amdgcn_sched_barrier(0)
    Unit cur, nxt; int ui = 0; typename Epi::Pre pre;
    if (!S.next(0, cur)) return;
    f32x4 acc[2][2][4][2];
#pragma unroll
    for (int a = 0; a < 2; ++a)
#pragma unroll
        for (int b = 0; b < 2; ++b)
#pragma unroll
            for (int m = 0; m < 4; ++m)
#pragma unroll
                for (int n = 0; n < 2; ++n) acc[a][b][m][n] = (f32x4){0.f, 0.f, 0.f, 0.f};
    bf16x8 At[4][2], B0[2][2], B1[2][2];
    const char* cA = (const char*)g.A + (size_t)cur.pm * tstep + (size_t)cur.ko * 2; const char* cB = (const char*)g.Bt + (size_t)cur.pn * tstep + (size_t)cur.ko * 2;
    S.a_ready(cur);
    if constexpr (SP2) {
        PG8_STAGE(PG8_SB(0, 0), cB, voffB); PG8_STAGE(PG8_SB(0, 1), cB + hstepB, voffB); PG8_STAGE(PG8_SA(0, 0), cA, voffA); PG8_STAGE(PG8_SA(0, 1), cA + hstep, voffA);
        if (wr == 1) PG8_BAR;
        PG8_WAIT_V(2); PG8_BAR;
        PG8_STAGE(PG8_SB(1, 0), cB + kstep, voffB); PG8_STAGE(PG8_SA(1, 0), cA + kstep, voffA); PG8_STAGE(PG8_SB(1, 1), cB + hstepB + kstep, voffB);
        PG8_WAIT_V(6); PG8_BAR;
    } else {
        PG8_STAGE(PG8_SB(0, 0), cB, voffB); PG8_STAGE(PG8_SA(0, 0), cA, voffA); PG8_STAGE(PG8_SB(0, 1), cB + hstepB, voffB); PG8_STAGE(PG8_SA(0, 1), cA + hstep, voffA);
        if (wr == 1) PG8_BAR;
        PG8_WAIT_V(4); PG8_BAR;
        PG8_STAGE(PG8_SB(1, 0), cB + kstep, voffB); PG8_STAGE(PG8_SA(1, 0), cA + kstep, voffA); PG8_STAGE(PG8_SB(1, 1), cB + hstepB + kstep, voffB);
        PG8_WAIT_V(6); PG8_BAR;
    }
    for (;;) {
        const bool has_next = S.next(ui + 1, nxt);
        const char* nA = has_next ? (const char*)g.A + (size_t)nxt.pm * tstep + (size_t)nxt.ko * 2 : cA; const char* nB = has_next ? (const char*)g.Bt + (size_t)nxt.pn * tstep + (size_t)nxt.ko * 2 : cB;
        for (int t = 0; t < nt; t += 2) {
            const bool last = (t == nt - 2);
            const char* a1 = cA + (size_t)(t + 1) * kstep;
            const char* a2 = last ? nA : cA + (size_t)(t + 2) * kstep; const char* b2 = last ? nB : cB + (size_t)(t + 2) * kstep;
            const char* a3 = a2 + kstep; const char* b3 = b2 + kstep;
            if (last && has_next) S.a_ready(nxt);
            if (last) E.prefetch(pre, cur, tid);
            if constexpr (SP2) {
            PG8_LDB(B0, 0, 0); PG8_LDB(B1, 0, 1); PG8_SCHED; PG8_LDA(At, 0, 0); PG8_STAGE(PG8_SA(1, 1), a1 + hstep, voffA);
            PG8_WAIT_V(8); PG8_WAIT_L(0); PG8_BAR; PG8_MMA(0, 0, At, B0); PG8_MMA(0, 1, At, B1); PG8_BAR; PG8_SCHED;
            PG8_LDA(At, 0, 1); PG8_STAGE(PG8_SB(0, 0), b2, voffB); PG8_STAGE(PG8_SB(0, 1), b2 + hstepB, voffB); PG8_STAGE(PG8_SA(0, 0), a2, voffA);
            PG8_WAIT_V(8); PG8_WAIT_L(0); PG8_BAR; PG8_MMA(1, 0, At, B0); PG8_MMA(1, 1, At, B1); PG8_BAR; PG8_SCHED;
            PG8_LDB(B0, 1, 0); PG8_LDB(B1, 1, 1); PG8_SCHED; PG8_LDA(At, 1, 0); PG8_STAGE(PG8_SA(0, 1), a2 + hstep, voffA);
            PG8_WAIT_V(8); PG8_WAIT_L(0); PG8_BAR; PG8_MMA(0, 0, At, B0); PG8_MMA(0, 1, At, B1); PG8_BAR; PG8_SCHED;
            PG8_LDA(At, 1, 1); PG8_STAGE(PG8_SB(1, 0), b3, voffB); PG8_STAGE(PG8_SB(1, 1), b3 + hstepB, voffB); PG8_STAGE(PG8_SA(1, 0), a3, voffA);
            PG8_WAIT_V(8); PG8_WAIT_L(0); PG8_BAR; PG8_MMA(1, 0, At, B0); PG8_MMA(1, 1, At, B1); PG8_BAR; PG8_SCHED;
            } else {
            PG8_LDB(B0, 0, 0); PG8_SCHED; PG8_LDA(At, 0, 0); PG8_STAGE(PG8_SA(1, 1), a1 + hstep, voffA);
            PG8_WAIT_L(8); PG8_BAR; PG8_WAIT_L(0); PG8_MMA(0, 0, At, B0); PG8_BAR; PG8_SCHED;
            PG8_LDB(B1, 0, 1); PG8_STAGE(PG8_SB(0, 0), b2, voffB);
            PG8_BAR; PG8_WAIT_L(0); PG8_MMA(0, 1, At, B1); PG8_BAR;
            PG8_LDA(At, 0, 1); PG8_STAGE(PG8_SA(0, 0), a2, voffA);
            PG8_BAR; PG8_WAIT_L(0); PG8_MMA(1, 0, At, B0); PG8_BAR; PG8_SCHED;
            PG8_STAGE(PG8_SB(0, 1), b2 + hstepB, voffB);
            PG8_WAIT_V(6); PG8_BAR; PG8_MMA(1, 1, At, B1); PG8_BAR;
            PG8_LDB(B0, 1, 0); PG8_SCHED; PG8_LDA(At, 1, 0); PG8_STAGE(PG8_SA(0, 1), a2 + hstep, voffA);
            PG8_WAIT_L(8); PG8_BAR; PG8_WAIT_L(0); PG8_MMA(0, 0, At, B0); PG8_BAR; PG8_SCHED;
            PG8_LDB(B1, 1, 1); PG8_STAGE(PG8_SB(1, 0), b3, voffB);
            PG8_BAR; PG8_WAIT_L(0); PG8_MMA(0, 1, At, B1); PG8_BAR;
            PG8_LDA(At, 1, 1); PG8_STAGE(PG8_SA(1, 0), a3, voffA);
            PG8_BAR; PG8_WAIT_L(0); PG8_MMA(1, 0, At, B0); PG8_BAR; PG8_SCHED;
            PG8_STAGE(PG8_SB(1, 1), b3 + hstepB, voffB);
            PG8_WAIT_V(6); PG8_BAR; PG8_MMA(1, 1, At, B1); PG8_BAR;
            }
        }
        if constexpr (ALIGN_EPI) { if (wr == 0) PG8_BAR; }
        if constexpr (!Epi::AFTER_DRAIN) { E(acc, cur, wr, wc, fr, fq, pre); S.done(cur); }
        if (!has_next) break;
#pragma unroll
        for (int a = 0; a < 2; ++a)
#pragma unroll
            for (int b = 0; b < 2; ++b)
#pragma unroll
                for (int m = 0; m < 4; ++m)
#pragma unroll
                    for (int n = 0; n < 2; ++n) acc[a][b][m][n] = (f32x4){0.f, 0.f, 0.f, 0.f};
        cur = nxt; cA = nA; cB = nB; ++ui;
        if constexpr (ALIGN_EPI) { if (wr == 1) PG8_BAR; }
    }
    PG8_WAIT_V(0);
    if constexpr (!ALIGN_EPI) { if (wr == 0) PG8_BAR; }
    PG8_BAR;
    if constexpr (Epi::AFTER_DRAIN) { E.fused(acc, cur, wr, wc, fr, fq, lds, wid, lane); S.done(cur); }
#undef PG8_SA
#undef PG8_SB
#undef PG8_STAGE
#undef PG8_LDA
#undef PG8_LDB
#undef PG8_MMA
#undef PG8_WAIT_V
#undef PG8_WAIT_L
#undef PG8_BAR
#undef PG8_SCHED
}
}

namespace fa {
constexpr int D = 128;
constexpr float THR = 8.f;
constexpr float SCALE = 0.08838834764831845f;
#ifndef FA_PRIO
#define FA_PRIO 0
#endif
constexpr int NW = 8, QBLK = 32, KVBLK = 64, QB = NW * QBLK;
constexpr int SHM_V = KVBLK * D * 2, SHM_K = KVBLK * D * 2;
constexpr int LDS_BYTES = 2 * SHM_V + 2 * SHM_K + NW * 64 * 4;
constexpr int OST_PITCH = 272, LDS_BYTES_OST = LDS_BYTES + NW * QBLK * OST_PITCH;

typedef unsigned short bf16;
typedef short bf16x8 __attribute__((ext_vector_type(8)));
typedef short s16x4 __attribute__((ext_vector_type(4)));
typedef float f32x16 __attribute__((ext_vector_type(16)));
typedef float f32x4 __attribute__((ext_vector_type(4)));
typedef unsigned u32x4 __attribute__((ext_vector_type(4)));
template <class A, class Bt> struct same_t { static constexpr bool v = false; };
template <class A> struct same_t<A, A> { static constexpr bool v = true; };

#define KSWZ(row, colB) ((row) * 256 + ((colB) ^ (((row) & 7) << 4)))
#define SBAR() __builtin_amdgcn_sched_barrier(0)
__device__ __forceinline__ int v_st(int k, int c) { const int kk = (k & ~0xC) | ((k & 4) << 1) | ((k & 8) >> 1); return ((kk >> 3) * 4 + (c >> 5)) * 512 + ((kk & 7) * 32 + (c & 31)) * 2; }
__device__ __forceinline__ int v_rd_base(int lane) { return ((lane & 3) << 3) | (((lane >> 2) & 3) << 6) | (((lane >> 4) & 1) << 5) | (((lane >> 5) & 1) << 8); }
constexpr int v_rd_off(int d0, int ks, int half) { return d0 * 512 + ks * 4096 + half * 2048; }
__device__ __forceinline__ int crow(int r, int hi) { return (r & 3) + 8 * (r >> 2) + 4 * hi; }
__device__ __forceinline__ unsigned cvtpk(float lo, float hi) {
    unsigned r; asm volatile("v_cvt_pk_bf16_f32 %0, %1, %2" : "=v"(r) : "v"(lo), "v"(hi)); return r;
}
__device__ __forceinline__ bf16x8 pack8(f32x4 a, f32x4 b) {
    u32x4 w = {cvtpk(a[0], a[1]), cvtpk(a[2], a[3]), cvtpk(b[0], b[1]), cvtpk(b[2], b[3])};
    return *reinterpret_cast<bf16x8*>(&w);
}
template <class T> __device__ __forceinline__ bf16x8 load8(const T* p) {
    if constexpr (same_t<T, float>::v) { return pack8(*(const f32x4*)p, *(const f32x4*)(p + 4)); }
    else { return *reinterpret_cast<const bf16x8*>(p); }
}
__device__ __forceinline__ void mask_tile(f32x16& p0, f32x16& p1, int dq, unsigned W) {
    const float NEG = -__builtin_inff();
#pragma unroll
    for (int r = 0; r < 16; ++r) {
        const int c = (r & 3) + 8 * (r >> 2);
        if ((unsigned)(dq - c) >= W) p0[r] = NEG;
        if ((unsigned)(dq - c - 32) >= W) p1[r] = NEG;
    }
}
__device__ __forceinline__ void sel_tile(f32x16& p0, f32x16& p1, bool keep) {
    const float NEG = -__builtin_inff();
#pragma unroll
    for (int r = 0; r < 16; ++r) { p0[r] = keep ? p0[r] : NEG; p1[r] = keep ? p1[r] : NEG; }
}
__device__ __forceinline__ void partialSM(f32x16& p0, f32x16& p1, float& m_reg, float& mn, float& alpha) {
    float pmax = p0[0]; for (int r = 1; r < 16; ++r) pmax = fmaxf(pmax, p0[r]); for (int r = 0; r < 16; ++r) pmax = fmaxf(pmax, p1[r]);
    { auto rr = __builtin_amdgcn_permlane32_swap(__float_as_uint(pmax), __float_as_uint(pmax), false, false);
      pmax = fmaxf(__uint_as_float(rr[0]), __uint_as_float(rr[1])); }
    constexpr float C2 = 1.4426950408889634f * SCALE;
    if (__builtin_expect(__all((pmax - m_reg) * SCALE <= THR), 1)) { mn = m_reg; alpha = 1.f; }
    else { mn = fmaxf(m_reg, pmax); alpha = __builtin_amdgcn_exp2f((m_reg - mn) * C2); m_reg = mn; }
    const float mnL = -mn * C2;
    for (int r = 0; r < 16; ++r) p0[r] = fmaf(p0[r], C2, mnL); for (int r = 0; r < 16; ++r) p1[r] = fmaf(p1[r], C2, mnL);
    for (int r = 0; r < 16; ++r) p0[r] = __builtin_amdgcn_exp2f(p0[r]);
}
__device__ __forceinline__ void finishSM(f32x16& p0, f32x16& p1, float alpha, float& l_reg, bf16x8& pa0, bf16x8& pa1, bf16x8& pa2, bf16x8& pa3) {
    for (int r = 0; r < 16; ++r) p1[r] = __builtin_amdgcn_exp2f(p1[r]);
    float ps = 0; for (int r = 0; r < 16; ++r) ps += p0[r]; for (int r = 0; r < 16; ++r) ps += p1[r];
    { auto rr = __builtin_amdgcn_permlane32_swap(__float_as_uint(ps), __float_as_uint(ps), false, false);
      ps = __uint_as_float(rr[0]) + __uint_as_float(rr[1]); }
    l_reg = l_reg * alpha + ps;
#define PK4(P, B_, OUT) do { unsigned a0 = cvtpk(P[B_+0], P[B_+1]), a1 = cvtpk(P[B_+2], P[B_+3]);                          \
        unsigned b0 = cvtpk(P[B_+4], P[B_+5]), b1 = cvtpk(P[B_+6], P[B_+7]);                                             \
        auto r0 = __builtin_amdgcn_permlane32_swap(a0, b0, false, false); auto r1 = __builtin_amdgcn_permlane32_swap(a1, b1, false, false); \
        u32x4 w = {r0[0], r1[0], r0[1], r1[1]}; OUT = *reinterpret_cast<bf16x8*>(&w); } while (0)
    PK4(p0, 0, pa0); PK4(p0, 8, pa1); PK4(p1, 0, pa2); PK4(p1, 8, pa3);
#undef PK4
}
template <int KB, bool SK>
__device__ __forceinline__ void qkt(f32x16& p0, f32x16& p1, const char* K_lds, int r32, int hi, const bf16x8* qr, bool act) {
    if (SK && !act) { const float NEG = -__builtin_inff();
#pragma unroll
        for (int r = 0; r < 16; ++r) { p0[r] = NEG; p1[r] = NEG; } return; }
    p0 = f32x16{}; p1 = f32x16{};
    if (FA_PRIO) __builtin_amdgcn_s_setprio(1);
    const char* kb[4];
#pragma unroll
    for (int dd = 0; dd < 4; ++dd) kb[dd] = K_lds + KB * SHM_K + KSWZ(r32, (dd * 16 + hi * 8) * 2);
#pragma unroll
    for (int d0 = 0; d0 < 8; ++d0) { const char* a = kb[d0 & 3] + (d0 >> 2) * 128;
        bf16x8 b0 = *reinterpret_cast<const bf16x8*>(a);
        bf16x8 b1 = *reinterpret_cast<const bf16x8*>(a + 32 * 256);
        p0 = __builtin_amdgcn_mfma_f32_32x32x16_bf16(b0, qr[d0], p0, 0, 0, 0);
        p1 = __builtin_amdgcn_mfma_f32_32x32x16_bf16(b1, qr[d0], p1, 0, 0, 0); }
    if (FA_PRIO) __builtin_amdgcn_s_setprio(0);
}
template <int VB, bool SK>
__device__ __forceinline__ void pv_tile(f32x16* o, int vb0, bf16x8 pa0, bf16x8 pa1, bf16x8 pa2, bf16x8 pa3, bool act) {
    if (SK && !act) return;
#define TRRD(dst, off) asm volatile("ds_read_b64_tr_b16 %0, %1 offset:%2" : "=&v"(dst) : "v"(vb0), "i"(off) : "memory")
#define PV_D0(d0) do { s16x4 l0, l1, l2, l3, h0, h1, h2, h3; constexpr int b_ = VB * SHM_V + v_rd_off(d0, 0, 0);     \
        TRRD(l0, b_); TRRD(h0, b_ + 2048); TRRD(l1, b_ + 4096); TRRD(h1, b_ + 6144); TRRD(l2, b_ + 8192); TRRD(h2, b_ + 10240); TRRD(l3, b_ + 12288); TRRD(h3, b_ + 14336); \
        asm volatile("s_waitcnt lgkmcnt(0)" ::: "memory"); SBAR();                 \
        o[d0] = __builtin_amdgcn_mfma_f32_32x32x16_bf16(pa0, (bf16x8){l0[0], l0[1], l0[2], l0[3], h0[0], h0[1], h0[2], h0[3]}, o[d0], 0, 0, 0);   \
        o[d0] = __builtin_amdgcn_mfma_f32_32x32x16_bf16(pa1, (bf16x8){l1[0], l1[1], l1[2], l1[3], h1[0], h1[1], h1[2], h1[3]}, o[d0], 0, 0, 0);   \
        o[d0] = __builtin_amdgcn_mfma_f32_32x32x16_bf16(pa2, (bf16x8){l2[0], l2[1], l2[2], l2[3], h2[0], h2[1], h2[2], h2[3]}, o[d0], 0, 0, 0);   \
        o[d0] = __builtin_amdgcn_mfma_f32_32x32x16_bf16(pa3, (bf16x8){l3[0], l3[1], l3[2], l3[3], h3[0], h3[1], h3[2], h3[3]}, o[d0], 0, 0, 0); } while (0)
    if (FA_PRIO) __builtin_amdgcn_s_setprio(1);
    PV_D0(0); PV_D0(1); PV_D0(2); PV_D0(3);
    if (FA_PRIO) __builtin_amdgcn_s_setprio(0);
#undef PV_D0
#undef TRRD
}

template <class TIn, class TOut> struct BlockRef { const TIn* Q; const TIn* K; const TIn* V; TOut* O; const unsigned* sel; int P0; int W; int os; int pk; };
template <class TIn> struct Seam {
    bf16x8 qr[8];
    bf16x8 st_v0, st_v1, st_k0, st_k1; f32x4 sf0, sf1, sf2, sf3;
    f32x4 tq[16];
};
constexpr int PK_HS = 2048 * D;
__device__ __forceinline__ int q_woff(int pk, int wid) { return pk ? (wid >> 1) * PK_HS + (wid & 1) * (QBLK * D) : wid * (QBLK * D); }
__device__ __forceinline__ int swa_jlo(int P0, int W) { const int lowk = P0 - W + 1; return lowk > 0 ? lowk / KVBLK : 0; }
#define ROW(p, k0, rr) ((p) + (size_t)((k0) + (rr)) * D + sc)
#define VMW() asm volatile("s_waitcnt vmcnt(0)" ::: "memory")
#define VMWN(n) asm volatile("s_waitcnt vmcnt(%0)" :: "i"(n) : "memory")
#define SLOAD_H(Kp, Vp, k0) do { S.st_v0 = load8<TIn>(ROW(Vp, k0, sr)); S.st_v1 = load8<TIn>(ROW(Vp, k0, 32 + sr));              \
                         S.st_k0 = load8<TIn>(ROW(Kp, k0, sr)); S.st_k1 = load8<TIn>(ROW(Kp, k0, 32 + sr)); } while (0)
#define SWRITE_HK(bf) do { *(bf16x8*)(K_lds + (bf) * SHM_K + kws) = S.st_k0; *(bf16x8*)(K_lds + (bf) * SHM_K + kws + 32 * 256) = S.st_k1; } while (0)
#define SWRITE_HV(bf) do { *(bf16x8*)(V_lds + (bf) * SHM_V + vst0) = S.st_v0; *(bf16x8*)(V_lds + (bf) * SHM_V + vst1) = S.st_v1; } while (0)
#define SWRITE_H(bf) do { SWRITE_HV(bf); SWRITE_HK(bf); } while (0)
#define SLOAD_F(p, k0) do { S.sf0 = *(const f32x4*)ROW(p, k0, sr); S.sf1 = *(const f32x4*)(ROW(p, k0, sr) + 4);                \
                            S.sf2 = *(const f32x4*)ROW(p, k0, 32 + sr); S.sf3 = *(const f32x4*)(ROW(p, k0, 32 + sr) + 4); } while (0)
#define SWRITE_KF(bf) do { *(bf16x8*)(K_lds + (bf) * SHM_K + kws) = pack8(S.sf0, S.sf1); *(bf16x8*)(K_lds + (bf) * SHM_K + kws + 32 * 256) = pack8(S.sf2, S.sf3); } while (0)
#define SWRITE_VF(bf) do { *(bf16x8*)(V_lds + (bf) * SHM_V + vst0) = pack8(S.sf0, S.sf1); *(bf16x8*)(V_lds + (bf) * SHM_V + vst1) = pack8(S.sf2, S.sf3); } while (0)
template <class TIn, class TOut>
__device__ __forceinline__ void causal_swa_prime(const BlockRef<TIn, TOut>& cur, char* lds, Seam<TIn>& S, const int wv) {
    const int W = cur.W;
    constexpr bool F32 = same_t<TIn, float>::v;
    const int tid = opaque_tid(wv), wid = __builtin_amdgcn_readfirstlane(tid >> 6), lane = tid & 63, r32 = lane & 31, hi = lane >> 5;
    const int sr = tid >> 4, sc = (tid & 15) * 8, kws = KSWZ(sr, sc * 2); char* K_lds = lds + 2 * SHM_V;
    const int kb0 = swa_jlo(cur.P0, W) * KVBLK;
    for (int d0 = 0; d0 < 8; ++d0) S.qr[d0] = load8<TIn>(cur.Q + q_woff(cur.pk, wid) + (size_t)r32 * D + d0 * 16 + hi * 8);
    if constexpr (F32) { SLOAD_F((const float*)cur.K, kb0); VMW(); SWRITE_KF(0); SBAR(); SLOAD_F((const float*)cur.V, kb0); }
    else { SLOAD_H(cur.K, cur.V, kb0); VMW(); SWRITE_HK(0); }
    __syncthreads();
}
template <class TOut> struct OutRef { TOut* O; int os; int pk; const float* gates; long dC, dS; };
template <class TIn, class TOut, class NX, class OX>
__device__ __forceinline__ void causal_swa_block(const BlockRef<TIn, TOut>& cur, const NX& nxf, const OX& oxf, int skv, char* lds, Seam<TIn>& S, const int wv) {
    const int W = cur.W;
    constexpr bool F32 = same_t<TIn, float>::v;
    const int tid = opaque_tid(wv), wid = __builtin_amdgcn_readfirstlane(tid >> 6), lane = tid & 63, r32 = lane & 31, hi = lane >> 5;
    const int j_lo = swa_jlo(cur.P0, W);
    int j_hi = (cur.P0 + (cur.pk ? 2 * QBLK : QB) - 1) / KVBLK + 1; if (j_hi > skv / KVBLK) j_hi = skv / KVBLK;
    const int NT = j_hi - j_lo;
    const int qlo = cur.P0 + (cur.pk ? (wid & 1) : wid) * QBLK, qm = qlo + r32 - 4 * hi;
    char* V_lds = lds; char* K_lds = lds + 2 * SHM_V;
    float* ws = (float*)(lds + 2 * SHM_V + 2 * SHM_K) + wid * 64; float* li_l = ws, * al_l = ws + 32;
    float m_reg = -1e30f, l_reg = 0; f32x16 o[4] = {};
    const bool has_sel = cur.sel != nullptr;
    const unsigned selw = has_sel ? cur.sel[qlo + r32] : 0xffffffffu;
    const int sr = tid >> 4, sc = (tid & 15) * 8, vst0 = v_st(sr, sc), vst1 = v_st(32 + sr, sc), kws = KSWZ(sr, sc * 2);
    const int vb0 = (int)(uintptr_t)V_lds + v_rd_base(lane);
    const TIn* Kh = cur.K; const TIn* Vh = cur.V;
#define RESC(a) do { if (__any((a) < 1.f)) { if (hi == 0) al_l[r32] = (a); asm volatile("s_waitcnt lgkmcnt(0)" ::: "memory");              \
                     for (int d_ = 0; d_ < 4; ++d_) for (int r = 0; r < 16; ++r) o[d_][r] *= al_l[crow(r, hi)]; } } while (0)
#define KBASE(t) ((j_lo + (t)) * KVBLK)
#define ACT(t) (KBASE(t) <= qlo + QBLK - 1 && KBASE(t) + KVBLK - 1 >= qlo - W + 1)
#define MASKT(P0_, P1_, t) do { const int kb_ = KBASE(t); if ((!SK || ACT(t)) && (kb_ + KVBLK - 1 > qlo || kb_ <= qlo + QBLK - 1 - W)) mask_tile(P0_, P1_, qm - kb_, (unsigned)W); \
        if (has_sel) sel_tile(P0_, P1_, ((selw >> (j_lo + (t))) & 1u) != 0u); } while (0)
    constexpr int NQL = F32 ? 16 : 8;
    constexpr bool SK = false;
#define SEAM_K0() do { VMWN(NQL); if constexpr (F32) { SWRITE_KF(0); SBAR(); SLOAD_F((const float*)nxt.V, kbn); } else { SWRITE_HK(0); } SBAR(); } while (0)
    f32x16 pA0, pA1, pB0, pB1; float mnA, mnB, alA, alB; bf16x8 pa0, pa1, pa2, pa3;
    if constexpr (F32) { VMW(); SWRITE_VF(0); SBAR(); } else { SWRITE_HV(0); SBAR(); }
    if (NT > 1) { if constexpr (F32) SLOAD_F((const float*)Kh, KBASE(1)); else SLOAD_H(Kh, Vh, KBASE(1)); }
    SBAR(); qkt<0, SK>(pA0, pA1, K_lds, r32, hi, S.qr, ACT(0));
    if constexpr (F32) { if (NT > 1) { VMW(); SWRITE_KF(1); SBAR(); SLOAD_F((const float*)Vh, KBASE(1)); } }
    MASKT(pA0, pA1, 0); partialSM(pA0, pA1, m_reg, mnA, alA);
    if (NT > 1) { VMW(); if constexpr (F32) { SWRITE_VF(1); SBAR(); if (NT > 2) SLOAD_F((const float*)Kh, KBASE(2)); } else SWRITE_H(1); }
    __syncthreads();
#define HALF_STEP(PX0, PX1, mnX, alX, PY0, PY1, alY, t, KB, VB, SB) do {                                                      \
        SBAR(); qkt<KB, SK>(PX0, PX1, K_lds, r32, hi, S.qr, ACT(t));                                             \
        finishSM(PY0, PY1, alY, l_reg, pa0, pa1, pa2, pa3); SBAR();                                                           \
        if ((t) + 1 < NT) { if constexpr (F32) { VMW(); SWRITE_KF(SB); SBAR(); SLOAD_F((const float*)Vh, KBASE((t) + 1)); }  \
                            else { SLOAD_H(Kh, Vh, KBASE((t) + 1)); } SBAR(); }                                               \
        pv_tile<VB, SK>(o, vb0, pa0, pa1, pa2, pa3, ACT((t) - 1)); MASKT(PX0, PX1, (t)); partialSM(PX0, PX1, m_reg, mnX, alX);                                        \
        __syncthreads();                                                                                                      \
        if ((t) + 1 < NT) { VMW(); if constexpr (F32) { SWRITE_VF(SB); SBAR(); if ((t) + 2 < NT) SLOAD_F((const float*)Kh, KBASE((t) + 2)); } \
                            else { SWRITE_H(SB); } }                                                                          \
        RESC(alX); __syncthreads(); } while (0)
    for (int t = 1; t + 1 < NT; t += 2) {
        HALF_STEP(pB0, pB1, mnB, alB, pA0, pA1, alA, t, 1, 0, 0);
        HALF_STEP(pA0, pA1, mnA, alA, pB0, pB1, alB, t + 1, 0, 1, 1);
    }
    const bool even = (NT & 1) == 0;
    if (even) { SBAR(); qkt<1, SK>(pB0, pB1, K_lds, r32, hi, S.qr, ACT(NT - 1)); SBAR(); }
    const BlockRef<TIn, TOut> nxt = nxf(); const int kbn = swa_jlo(nxt.P0, nxt.W) * KVBLK;
#define QROW(e) (nxt.Q + q_woff(nxt.pk, wid) + (size_t)r32 * D + ((e) >> 1) * 16 + hi * 8 + ((e) & 1) * 4)
    if constexpr (F32) { SLOAD_F((const float*)nxt.K, kbn); SBAR();
#pragma unroll
        for (int e = 0; e < 8; ++e) S.tq[e] = *(const f32x4*)QROW(e); }
    else { SLOAD_H(nxt.K, nxt.V, kbn); SBAR();
#pragma unroll
        for (int d0 = 0; d0 < 8; ++d0) S.qr[d0] = load8<TIn>(nxt.Q + q_woff(nxt.pk, wid) + (size_t)r32 * D + d0 * 16 + hi * 8); }
    SBAR();
    finishSM(pA0, pA1, alA, l_reg, pa0, pa1, pa2, pa3); SBAR();
    if constexpr (F32) {
#pragma unroll
        for (int e = 8; e < 16; ++e) S.tq[e] = *(const f32x4*)QROW(e); SBAR(); }
#undef QROW
    pv_tile<0, SK>(o, vb0, pa0, pa1, pa2, pa3, ACT(even ? NT - 2 : NT - 1));
    if (even) { MASKT(pB0, pB1, NT - 1); partialSM(pB0, pB1, m_reg, mnB, alB); __syncthreads(); RESC(alB);
        finishSM(pB0, pB1, alB, l_reg, pa0, pa1, pa2, pa3); SBAR(); pv_tile<1, SK>(o, vb0, pa0, pa1, pa2, pa3, ACT(NT - 1)); }
    SBAR(); SEAM_K0();
    if (hi == 0) li_l[r32] = l_reg; asm volatile("s_waitcnt lgkmcnt(0)" ::: "memory");
    float rli[16];
#pragma unroll
    for (int r = 0; r < 16; ++r) rli[r] = __builtin_amdgcn_rcpf(li_l[crow(r, hi)]);
    const OutRef<TOut> orf = oxf(); const int os = orf.os; TOut* Ow = orf.O + (orf.pk ? (size_t)(wid >> 1) * D + (size_t)((wid & 1) * QBLK) * os : (size_t)(wid * QBLK) * os);
    char* ost = lds + LDS_BYTES + wid * (QBLK * OST_PITCH);
#pragma unroll
    for (int r = 0; r < 16; ++r) { const int orow = crow(r, hi);
#pragma unroll
        for (int d0 = 0; d0 < 4; ++d0) { const float v = o[d0][r] * rli[r];
            if constexpr (same_t<TOut, float>::v) { Ow[(size_t)orow * os + d0 * 32 + r32] = v; }
            else { *(unsigned short*)(ost + orow * OST_PITCH + (d0 * 32 + r32) * 2) = (unsigned short)cvtpk(v, v); } } }
    if constexpr (!same_t<TOut, float>::v) {
        asm volatile("s_waitcnt lgkmcnt(0)" ::: "memory");
#pragma unroll
        for (int it = 0; it < 8; ++it) { const int row = it * 4 + (lane >> 4), cb = (lane & 15) * 16;
            const u32x4 w = *reinterpret_cast<const u32x4*>(ost + row * OST_PITCH + cb);
            char* dst = reinterpret_cast<char*>(Ow + (size_t)row * os) + cb;
            if (orf.gates != nullptr) {
                const f32x4 g4 = *reinterpret_cast<const f32x4*>(orf.gates + ((size_t)((wid & 1) * QBLK + row) * 16 + (wid >> 1)) * 4);
                const u32x4 c4 = *reinterpret_cast<const u32x4*>(dst + orf.dC), s4 = *reinterpret_cast<const u32x4*>(dst + orf.dS);
                u32x4 o4;
#pragma unroll
                for (int q = 0; q < 4; ++q) {
                    const float lo = g4[0] * __uint_as_float(c4[q] << 16) + g4[1] * __uint_as_float(s4[q] << 16) + g4[2] * __uint_as_float(w[q] << 16);
                    const float hv = g4[0] * __uint_as_float(c4[q] & 0xffff0000u) + g4[1] * __uint_as_float(s4[q] & 0xffff0000u) + g4[2] * __uint_as_float(w[q] & 0xffff0000u);
                    o4[q] = cvtpk(lo, hv); }
                *reinterpret_cast<u32x4*>(dst) = o4;
            } else *reinterpret_cast<u32x4*>(dst) = w; } }
    if constexpr (F32) {
#pragma unroll
        for (int d0 = 0; d0 < 8; ++d0) S.qr[d0] = pack8(S.tq[2 * d0], S.tq[2 * d0 + 1]); }
    __syncthreads();
#undef RESC
#undef KBASE
#undef ACT
#undef MASKT
#undef SEAM_K0
#undef HALF_STEP
}
#undef ROW
#undef VMW
#undef VMWN
#undef SLOAD_H
#undef SWRITE_HK
#undef SWRITE_HV
#undef SWRITE_H
#undef SLOAD_F
#undef SWRITE_KF
#undef SWRITE_VF

}

#define GAS __attribute__((address_space(1)))
#define LAS __attribute__((address_space(3)))
typedef unsigned short bf16;
typedef unsigned v4u __attribute__((ext_vector_type(4)));
typedef float f32x4 __attribute__((ext_vector_type(4)));
typedef short bf16x8 __attribute__((ext_vector_type(8)));
typedef GAS unsigned gu32;
typedef GAS unsigned long long gu64;
#define RLX_AGENT __ATOMIC_RELAXED, __HIP_MEMORY_SCOPE_AGENT
#define LDS_WAIT() asm volatile("s_waitcnt lgkmcnt(0)" ::: "memory")
#define VM_WAIT() asm volatile("s_waitcnt vmcnt(0)" ::: "memory")
__device__ __forceinline__ unsigned long long rt() { return __builtin_amdgcn_s_memrealtime(); }
__device__ __forceinline__ unsigned f2bf(float f) { unsigned u = __builtin_bit_cast(unsigned, f); return (u + 0x7fffu + ((u >> 16) & 1u)) >> 16; }
__device__ __forceinline__ unsigned pk2(float lo, float hi) { return f2bf(lo) | (f2bf(hi) << 16); }

#define XB_TMO      128
#define XB_XCNT(j)  (256  + 64 * (j))
#define XB_XSUB(j)  (1280 + 64 * (j))
#define XB_XGEN(j)  (2304 + 64 * (j))
#define XB_TOP      3328
#define XB_TOPGEN   3392
#define XCD_BAR_WORDS 3456
#define XB_SPIN_CAP (1u << 18)

__device__ __forceinline__ unsigned xb_ld(unsigned* p)              { return __hip_atomic_load(p, __ATOMIC_RELAXED, __HIP_MEMORY_SCOPE_AGENT); }
__device__ __forceinline__ unsigned xb_add(unsigned* p, unsigned v) { return __hip_atomic_fetch_add(p, v, __ATOMIC_RELAXED, __HIP_MEMORY_SCOPE_AGENT); }
__device__ __forceinline__ unsigned xb_xcc_id() { return (unsigned)__builtin_amdgcn_s_getreg((3 << 11) | 20) & 0xFu; }
#define XB_SPIN(cond, bar) do { unsigned _sp = 0; while (cond) { __builtin_amdgcn_s_sleep(1); \
    if ((++_sp & 255u) == 0u) { if (xb_ld(&(bar)[XB_TMO])) break; if (_sp > XB_SPIN_CAP) { atomicAdd(&(bar)[XB_TMO], 1u); break; } } } } while (0)

struct XcdBarrier {
    unsigned* bar; unsigned x; unsigned G;
    volatile LAS unsigned* st;
};

__device__ __forceinline__ XcdBarrier xcd_barrier_post(unsigned* bar, volatile LAS unsigned* st, unsigned G) {
    XcdBarrier b; b.bar = bar; b.x = xb_xcc_id(); b.st = st; b.G = G;
    if (threadIdx.x == 0) (void)xb_add(&bar[XB_XCNT(b.x)], 1u);
    return b;
}
__device__ __forceinline__ void xcd_barrier_complete(unsigned* bar, unsigned x, unsigned G, unsigned& nloc, unsigned& nx) {
    unsigned sum, cnt, mine, sp = 0u;
    for (;;) {
        sum = 0u; cnt = 0u; mine = 0u;
#pragma unroll
        for (unsigned j = 0; j < 16; ++j) { const unsigned c = xb_ld(&bar[XB_XCNT(j)]); sum += c; cnt += (c > 0u) ? 1u : 0u; mine = (j == x) ? c : mine; }
        if (sum == G) break;
        __builtin_amdgcn_s_sleep(1);
        if ((++sp & 255u) == 0u) { if (xb_ld(&bar[XB_TMO])) break; if (sp > XB_SPIN_CAP) { atomicAdd(&bar[XB_TMO], 1u); break; } }
    }
    nloc = mine > 0u ? mine : 1u; nx = cnt > 0u ? cnt : 1u;
}

__device__ __forceinline__ void xcd_barrier(const XcdBarrier& b) {
    asm volatile("s_waitcnt vmcnt(0)" ::: "memory");
    __syncthreads();
    if (threadIdx.x == 0) {
        unsigned* bar = b.bar;
        __builtin_amdgcn_s_waitcnt(0);
        unsigned nloc = b.st[0], nx = b.st[1];
        if (nloc == 0u) { xcd_barrier_complete(bar, b.x, b.G, nloc, nx); b.st[0] = nloc; b.st[1] = nx; }
        const unsigned old = xb_add(&bar[XB_XSUB(b.x)], 1u);
        const unsigned gen = old / nloc;
        if (old + 1u == (gen + 1u) * nloc) {
            __builtin_amdgcn_fence(__ATOMIC_RELEASE, "agent");
            asm volatile("s_waitcnt vmcnt(0)" ::: "memory");
            const unsigned og = xb_add(&bar[XB_TOP], 1u);
            const unsigned tg = og / nx;
            if (og + 1u == (tg + 1u) * nx) xb_add(&bar[XB_TOPGEN], 1u);
            else XB_SPIN(xb_ld(&bar[XB_TOPGEN]) == tg, bar);
            __builtin_amdgcn_fence(__ATOMIC_ACQUIRE, "agent");
            xb_add(&bar[XB_XGEN(b.x)], 1u);
            asm volatile("s_waitcnt vmcnt(0)" ::: "memory");
        } else {
            XB_SPIN(xb_ld(&bar[XB_XGEN(b.x)]) == gen, bar);
            __builtin_amdgcn_fence(__ATOMIC_ACQUIRE, "agent");
            asm volatile("s_waitcnt vmcnt(0)" ::: "memory");
        }
    }
    __syncthreads();
}

#define DEVI __device__ __forceinline__
typedef float f32x16 __attribute__((ext_vector_type(16)));
typedef unsigned u32x2 __attribute__((ext_vector_type(2)));
typedef float f32x2 __attribute__((ext_vector_type(2)));

struct Ctx { LAS unsigned char* lds; char* ldsg; int tid, lane, wave, bid, vcu, G, gw, NGW; int m0, MS, b0, NBS; };
DEVI const float* inp(const Ctx& F, int k) { const LAS unsigned* p = (const LAS unsigned*)(F.lds + PTR_OFF) + 2 * k; const unsigned lo = __builtin_amdgcn_readfirstlane(p[0]), hi = __builtin_amdgcn_readfirstlane(p[1]);
    return (const float*)(((unsigned long long)hi << 32) | lo); }

__device__ const float ROPE_INV[64] = {
1.000000000e+00f, 8.659643531e-01f, 7.498942018e-01f, 6.493816376e-01f, 5.623413324e-01f, 4.869675338e-01f, 4.216965139e-01f, 3.651741147e-01f, 3.162277639e-01f, 2.738419771e-01f, 2.371373773e-01f, 2.053525001e-01f, 1.778279394e-01f, 1.539926529e-01f, 1.333521456e-01f, 1.154781953e-01f,
1.000000015e-01f, 8.659642935e-02f, 7.498942316e-02f, 6.493816525e-02f, 5.623413250e-02f, 4.869675264e-02f, 4.216964915e-02f, 3.651741147e-02f, 3.162277490e-02f, 2.738419548e-02f, 2.371373773e-02f, 2.053525113e-02f, 1.778279431e-02f, 1.539926510e-02f, 1.333521400e-02f, 1.154781971e-02f,
9.999999776e-03f, 8.659643121e-03f, 7.498942316e-03f, 6.493816152e-03f, 5.623413250e-03f, 4.869675264e-03f, 4.216964822e-03f, 3.651741194e-03f, 3.162277630e-03f, 2.738419687e-03f, 2.371373819e-03f, 2.053525066e-03f, 1.778279431e-03f, 1.539926510e-03f, 1.333521446e-03f, 1.154782018e-03f,
1.000000047e-03f, 8.659643354e-04f, 7.498941850e-04f, 6.493816036e-04f, 5.623413017e-04f, 4.869675322e-04f, 4.216965172e-04f, 3.651741135e-04f, 3.162277571e-04f, 2.738419571e-04f, 2.371373703e-04f, 2.053525095e-04f, 1.778279402e-04f, 1.539926598e-04f, 1.333521504e-04f, 1.154782003e-04f};

DEVI float bflo(unsigned w) { return __uint_as_float(w << 16); }
DEVI float bfhi(unsigned w) { return __uint_as_float(w & 0xffff0000u); }
DEVI float wave_sum(float v) {
#pragma unroll
    for (int o = 1; o < 64; o <<= 1) v += __shfl_xor(v, o);
    return v;
}
DEVI f32x16 mfma32(bf16x8 a, bf16x8 b, f32x16 c) { return __builtin_amdgcn_mfma_f32_32x32x16_bf16(a, b, c, 0, 0, 0); }
DEVI int crow(int r, int hi) { return (r & 3) + 8 * (r >> 2) + 4 * hi; }

DEVI int wrow_perm(int n, int perm) {
    const bool p = perm == 2 ? n < 4096 : (perm == 1 && (n < 2048 || (n >= 3072 && n < 3584) || (n >= 4096 && n < 4608)));
    if (!p) return n; const int d = n & 127; return (n & ~127) + 8 * ((d & 63) >> 2) + 4 * (d >> 6) + (d & 3); }
DEVI void tr_item(const float* W, int K, int N, bf16* WT, LAS float* scr, int kb, int nb, int lane, int perm) {
    const int k0 = 64 * kb, n0 = 64 * nb, kr = lane >> 4, nq = lane & 15; const bool ok = n0 + 4 * nq < N;
    const GAS float* src = (const GAS float*)W + (size_t)k0 * N + n0;
    const int loff = kr * N + 4 * nq;
    f32x4 v[16];
#pragma unroll
    for (int i = 0; i < 16; ++i) v[i] = ok ? *(const GAS f32x4*)(src + (size_t)(4 * i) * N + loff) : (f32x4){0.f, 0.f, 0.f, 0.f};
#pragma unroll
    for (int i = 0; i < 16; ++i) { LAS float* d = scr + (4 * i + kr) * 65 + 4 * nq; d[0] = v[i].x; d[1] = v[i].y; d[2] = v[i].z; d[3] = v[i].w; }
    LDS_WAIT(); asm volatile("" ::: "memory");
    const int c = lane & 7, nr = lane >> 3;
#pragma unroll
    for (int j = 0; j < 8; ++j) { const int n = nr + 8 * j; const LAS float* s = scr + (8 * c) * 65 + n;
        v4u o; o.x = pk2(s[0 * 65], s[1 * 65]); o.y = pk2(s[2 * 65], s[3 * 65]); o.z = pk2(s[4 * 65], s[5 * 65]); o.w = pk2(s[6 * 65], s[7 * 65]);
        if (perm == 3) { const int f = n0 + n, k = k0 + 8 * c;
            *(GAS v4u*)(WT + ((((size_t)(f >> 5) * 8 + (k >> 9)) * 32 + ((k & 511) >> 4)) * 64 + (((k >> 3) & 1) * 32 + (f & 31))) * 8) = o; }
        else *(GAS v4u*)(WT + (size_t)wrow_perm(n0 + n, perm) * K + k0 + 8 * c) = o; }
    LDS_WAIT(); asm volatile("" ::: "memory");
}

DEVI void p0_weights(const Ctx& F, unsigned char* ws, int defer);
DEVI void p0_prologue(const Ctx& F, unsigned char* ws, int defer) {
    LAS float* scL = (LAS float*)(F.lds);
    { const float* cc = inp(F, 1);
      for (int idx = F.tid; idx < NB * DM; idx += NWAVES * 64) { const int b = idx >> 11, k = idx & 2047; const float v = cc[idx]; scL[k * 8 + b] = v / (1.f + expf(-v)); } }
    __syncthreads();
    { const GAS float* adaw = (const GAS float*)inp(F, 3);
    for (int id = F.gw; id < 1536; id += F.NGW) {
        const int l = id / 384, rem = id % 384, ks = rem / 48, cg = rem % 48, colu = cg * 256, col0 = colu + 4 * F.lane, k0 = ks * 256, loff = 4 * F.lane;
        const GAS float* wp = adaw + ((size_t)l * DM + k0) * MODW + colu;
        f32x4 a0 = {0, 0, 0, 0}, a1 = a0, a2 = a0, a3 = a0, a4 = a0, a5 = a0, a6 = a0, a7 = a0;
        for (int kk = 0; kk < 256; kk += 8) {
            f32x4 w[8];
#pragma unroll
            for (int u = 0; u < 8; ++u) w[u] = *(const GAS f32x4*)(wp + (size_t)(kk + u) * MODW + loff);
#pragma unroll
            for (int u = 0; u < 8; ++u) { const f32x4 s0 = *(const LAS f32x4*)(scL + (k0 + kk + u) * 8), s1 = *(const LAS f32x4*)(scL + (k0 + kk + u) * 8 + 4);
                a0 += s0.x * w[u]; a1 += s0.y * w[u]; a2 += s0.z * w[u]; a3 += s0.w * w[u]; a4 += s1.x * w[u]; a5 += s1.y * w[u]; a6 += s1.z * w[u]; a7 += s1.w * w[u]; }
        }
        float* pp = (float*)(ws + WS_MODP) + (((size_t)ks * 4 + l) * 8) * MODW + col0;
        *(GAS f32x4*)(pp + 0 * MODW) = a0; *(GAS f32x4*)(pp + 1 * MODW) = a1; *(GAS f32x4*)(pp + 2 * MODW) = a2; *(GAS f32x4*)(pp + 3 * MODW) = a3;
        *(GAS f32x4*)(pp + 4 * MODW) = a4; *(GAS f32x4*)(pp + 5 * MODW) = a5; *(GAS f32x4*)(pp + 6 * MODW) = a6; *(GAS f32x4*)(pp + 7 * MODW) = a7;
    } }
    { const int* pos = (const int*)inp(F, 2); float* rope = (float*)(ws + WS_ROPE); const float inv = ROPE_INV[F.lane];
      for (int m = F.gw; m < M; m += F.NGW) { const float ang = (float)pos[m] * inv; const double rev = (double)ang * 0.15915494309189535; const float fr = (float)(rev - rint(rev));
          ((GAS unsigned*)rope)[(size_t)m * 64 + F.lane] = pg8::cvt_pk_f16(__builtin_amdgcn_cosf(fr), __builtin_amdgcn_sinf(fr)); } }
    __syncthreads();
    p0_weights(F, ws, defer);
}
DEVI void p0_weights(const Ctx& F, unsigned char* ws, int defer) {
    LAS float* scr = (LAS float*)(F.lds + F.wave * 16640);
    constexpr int I_W1 = 32 * 128, I_W2 = 128 * 32, I_NI = 32 * 84, I_NO = 32 * 32, I_DI = 32 * 96, I_DO = 32 * 32, I_C1 = 64 * 4, I_C2 = 4 * 2;
    constexpr int NITEMS = 4 * I_W1 + 4 * I_W2 + 2 * (I_NI + I_NO + I_DI + I_DO) + 4 * I_C1 + 4 * I_C2;
    for (int it = F.gw; it < NITEMS; it += F.NGW) {
        int r = it; const float* W; bf16* WT; int K, N, nblk, perm = 0;
        { const bool l3 = r >= 4 * I_W1 + 2 * I_W2 && r < 4 * I_W1 + 4 * I_W2; if ((defer == 1 && l3) || (defer == 2 && !l3)) continue; }
        if (r < 4 * I_W1) { const int l = r / I_W1; r -= l * I_W1; W = inp(F, 7) + (size_t)l * DM * DFF; WT = (bf16*)(ws + WS_W1T) + (size_t)l * DFF * DM; K = DM; N = DFF; nblk = 128; }
        else if ((r -= 4 * I_W1) < 4 * I_W2) { const int l = r / I_W2; r -= l * I_W2; W = inp(F, 8) + (size_t)l * DFF * DM; WT = (bf16*)(ws + WS_W2T) + (size_t)l * DM * DFF; K = DFF; N = DM; nblk = 32; }
        else if ((r -= 4 * I_W2) < 2 * I_NI) { const int j = r / I_NI; r -= j * I_NI; W = inp(F, 9) + (size_t)j * DM * NSA_IN; WT = (bf16*)(ws + WS_NWIN) + (size_t)j * NSA_INP * DM; K = DM; N = NSA_IN; nblk = 84; perm = 1; }
        else if ((r -= 2 * I_NI) < 2 * I_NO) { const int j = r / I_NO; r -= j * I_NO; W = inp(F, 10) + (size_t)j * DM * DM; WT = (bf16*)(ws + WS_NWOUT) + (size_t)j * DM * DM; K = DM; N = DM; nblk = 32; }
        else if ((r -= 2 * I_NO) < 2 * I_DI) { const int j = r / I_DI; r -= j * I_DI; W = inp(F, 16) + (size_t)j * DM * DIFF_IN; WT = (bf16*)(ws + WS_DWIN) + (size_t)j * DIFF_IN * DM; K = DM; N = DIFF_IN; nblk = 96; perm = 2; }
        else if ((r -= 2 * I_DI) < 2 * I_DO) { const int j = r / I_DO; r -= j * I_DO; W = inp(F, 17) + (size_t)j * DM * DM; WT = (bf16*)(ws + WS_DWOUT) + (size_t)j * DM * DM; K = DM; N = DM; nblk = 32; }
        else if ((r -= 2 * I_DO) < 4 * I_C1) { const int q = r / I_C1; r -= q * I_C1; W = inp(F, 14) + (size_t)q * 4096 * 256; WT = (bf16*)(ws + WS_CW1) + (size_t)q * 256 * 4096; K = 4096; N = 256; nblk = 4; perm = 3; }
        else { r -= 4 * I_C1; const int q = r / I_C2; r -= q * I_C2; W = inp(F, 15) + (size_t)q * 256 * 128; WT = (bf16*)(ws + WS_CW2) + (size_t)q * 128 * 256; K = 256; N = 128; nblk = 2; }
        tr_item(W, K, N, WT, scr, r / nblk, r % nblk, F.lane, perm);
    }
}

DEVI void p1_mod(const Ctx& F, unsigned char* ws) {
    const float* part = (const float*)(ws + WS_MODP); float* mod = (float*)(ws + WS_MOD); const float* ab = inp(F, 4); float* gsb = (float*)(ws + WS_GS); const float* ag = inp(F, 5); const float* mg = inp(F, 6);
    const int gt = (F.vcu * NWAVES + F.wave) * 64 + F.lane, GT = F.NGW * 64;
    for (int idx = gt; idx < 4 * NB * MODW; idx += GT) { const int l = idx / (NB * MODW), rem = idx - l * (NB * MODW), e = rem % MODW;
        float s = ab[l * MODW + e];
#pragma unroll
        for (int ks = 0; ks < 8; ++ks) s += part[((size_t)ks * 4 + l) * (NB * MODW) + rem];
        mod[idx] = s;
        const int seg = e / DM, c = e - seg * DM, b = rem / MODW;
        if (seg == 1) gsb[((size_t)(2 * l) * NB + b) * DM + c] = ag[l * DM + c] * (1.f + s);
        if (seg == 4) gsb[((size_t)(2 * l + 1) * NB + b) * DM + c] = mg[l * DM + c] * (1.f + s); }
}

DEVI void p2_first(const Ctx& F, unsigned char* ws) {
    { const float* x = inp(F, 0); const float* gs = (const float*)(ws + WS_GS); bf16* out = (bf16*)(ws + WS_H); float* ssq = (float*)(ws + WS_SSQ);
      const int wpb = F.NGW >> 3, b = F.gw / wpb, wl = F.gw - b * wpb;
      if (b < NB) {
        f32x4 g[4][2];
#pragma unroll
        for (int j = 0; j < 4; ++j) { g[j][0] = *(const GAS f32x4*)(gs + (size_t)b * DM + 8 * F.lane + 512 * j); g[j][1] = *(const GAS f32x4*)(gs + (size_t)b * DM + 8 * F.lane + 512 * j + 4); }
        for (int t = wl; t < T; t += wpb) { const int m = b * T + t;
            const GAS float* xr = (const GAS float*)x + (size_t)m * DM + 8 * F.lane;
            f32x4 v[4][2]; float ss = 0.f;
#pragma unroll
            for (int j = 0; j < 4; ++j) { v[j][0] = *(const GAS f32x4*)(xr + 512 * j); v[j][1] = *(const GAS f32x4*)(xr + 512 * j + 4);
                ss += ((v[j][0].x * v[j][0].x + v[j][0].y * v[j][0].y) + (v[j][0].z * v[j][0].z + v[j][0].w * v[j][0].w)) + ((v[j][1].x * v[j][1].x + v[j][1].y * v[j][1].y) + (v[j][1].z * v[j][1].z + v[j][1].w * v[j][1].w)); }
            ss = wave_sum(ss);
            if (F.lane < 8) ssq[(size_t)m * 8 + F.lane] = F.lane == 0 ? ss : 0.f;
#pragma unroll
            for (int j = 0; j < 4; ++j) { const f32x4 y0 = v[j][0] * g[j][0], y1 = v[j][1] * g[j][1];
                v4u w; w.x = pk2(y0.x, y0.y); w.y = pk2(y0.z, y0.w); w.z = pk2(y1.x, y1.y); w.w = pk2(y1.z, y1.w);
                *(GAS v4u*)(out + (size_t)m * DM + 8 * F.lane + 512 * j) = w; } } } }
    LAS bf16* shL = (LAS bf16*)(F.lds);
    const int r = F.lane & 31, hi = F.lane >> 5;
    {
        const int site = F.bid & 7, wi = (F.bid >> 3) * NWAVES + F.wave, nwi = (F.G >> 3) * NWAVES;
        const int l = site >> 1, which = site & 1, j = l >> 1;
        const float* sh = (const float*)(ws + WS_MOD) + (size_t)l * NB * MODW + (which ? 3 * DM : 0);
        const bf16* Wt; int N;
        if (which) { Wt = (const bf16*)(ws + WS_W1T) + (size_t)l * DFF * DM; N = DFF; }
        else if ((l & 1) == 0) { Wt = (const bf16*)(ws + WS_NWIN) + (size_t)j * NSA_INP * DM; N = NSA_INP; }
        else { Wt = (const bf16*)(ws + WS_DWIN) + (size_t)j * DIFF_IN * DM; N = DIFF_IN; }
        __syncthreads();
        for (int idx = F.tid; idx < NB * DM / 4; idx += NWAVES * 64) { const int b = idx >> 9, k = (idx & 511) * 4; const f32x4 v = *(const GAS f32x4*)(sh + (size_t)b * MODW + k);
            u32x2 w; w.x = pk2(v.x, v.y); w.y = pk2(v.z, v.w); *(LAS u32x2*)(shL + b * DM + k) = w; }
        __syncthreads();
        float* dst = (float*)(ws + WS_SHW) + (size_t)site * NB * 8192;
        for (int t = wi; t < N / 32; t += nwi) {
            const GAS bf16* brow = (const GAS bf16*)Wt + (size_t)(t * 32 + r) * DM + 8 * hi;
            f32x16 acc = {};
#pragma unroll 1
            for (int k0 = 0; k0 < DM; k0 += 256) {
                bf16x8 bb[16];
#pragma unroll
                for (int q = 0; q < 16; ++q) bb[q] = *(const GAS bf16x8*)(brow + k0 + 16 * q);
#pragma unroll
                for (int q = 0; q < 16; ++q) { bf16x8 a = *(const LAS bf16x8*)(shL + (r & 7) * DM + k0 + 16 * q + 8 * hi); if (r >= 8) a = (bf16x8){0, 0, 0, 0, 0, 0, 0, 0};
                    acc = mfma32(a, bb[q], acc); }
            }
#pragma unroll
            for (int rg = 0; rg < 4; ++rg) dst[(size_t)(rg + 4 * hi) * 8192 + t * 32 + r] = acc[rg];
        }
    }
    __syncthreads();
}

DEVI bf16x8 add_pos8(v4u a, f32x4 p0, f32x4 p1) {
    v4u o; o.x = pk2(bflo(a.x) + p0.x, bfhi(a.x) + p0.y); o.y = pk2(bflo(a.y) + p0.z, bfhi(a.y) + p0.w); o.z = pk2(bflo(a.z) + p1.x, bfhi(a.z) + p1.y); o.w = pk2(bflo(a.w) + p1.z, bfhi(a.w) + p1.w);
    return __builtin_bit_cast(bf16x8, o);
}
DEVI void compress_unit(const Ctx& F, unsigned char* ws, int j, int u) {
    const int per = F.NBS * 16, kv = u / per, ur = u - kv * per, b = F.b0 + (ur >> 4), g = (ur >> 2) & 3, n0 = (ur & 3) * 32;
    const int lane = F.lane, w = F.wave, r = lane & 31, hi = lane >> 5;
    const bf16* raw = (const bf16*)(ws + WS_RAW);
    const GAS float* pos = (const GAS float*)inp(F, 13) + (size_t)(j * 2 + kv) * 4096;
    const bf16* W1t = (const bf16*)(ws + WS_CW1) + (size_t)(j * 2 + kv) * 256 * 4096;
    const bf16* W2t = (const bf16*)(ws + WS_CW2) + (size_t)(j * 2 + kv) * 128 * 256;
    constexpr int AROW = 136, ABUF = 4 * 32 * AROW * 2;
    LAS bf16* abuf = (LAS bf16*)(F.lds);
    LAS bf16* hidL = (LAS bf16*)(F.lds + 2 * ABUF);
    LAS float* outL = (LAS float*)(F.lds + 2 * ABUF + 32768);
    const int sl4 = F.tid >> 7, sn = (F.tid >> 2) & 31, sq = F.tid & 3, snn = n0 + sn; const bool sok = snn <= 126;
    const GAS bf16* asrc = (const GAS bf16*)raw + (size_t)(b * T + 16 * (sok ? snn : 0) + sl4) * NSA_INP + 2048 + kv * 512 + g * 128 + 32 * sq;
    const GAS float* psrc = pos + sl4 * 128 + 32 * sq;
    v4u ar[4]; f32x4 pr[8];
#define CMP_ALOAD(lg) do { _Pragma("unroll") for (int c = 0; c < 4; ++c) { ar[c] = *(const GAS v4u*)(asrc + (size_t)(4 * (lg)) * NSA_INP + 8 * c); \
        pr[2 * c] = *(const GAS f32x4*)(psrc + (lg) * 512 + 8 * c); pr[2 * c + 1] = *(const GAS f32x4*)(psrc + (lg) * 512 + 8 * c + 4); } } while (0)
#define CMP_AWRITE(lg, buf) do { _Pragma("unroll") for (int c = 0; c < 4; ++c) { \
        bf16x8 a = add_pos8(ar[c], pr[2 * c], pr[2 * c + 1]); if (!sok) a = (bf16x8){0, 0, 0, 0, 0, 0, 0, 0}; *(LAS bf16x8*)(abuf + (buf) * (ABUF / 2) + (sl4 * 32 + sn) * AROW + 32 * sq + 8 * c) = a; } } while (0)
    const GAS bf16* brow = (const GAS bf16*)W1t + (size_t)w * (8 * 32 * 512) + lane * 8;
    f32x16 acc = {};
    bf16x8 bA[16], bB[16];
#pragma unroll
    for (int q = 0; q < 16; ++q) bA[q] = *(const GAS bf16x8*)(brow + q * 512);
    CMP_ALOAD(0); CMP_AWRITE(0, 0);
    __syncthreads();
#pragma unroll 1
    for (int lg = 0; lg < 8; ++lg) {
#pragma unroll
        for (int q = 0; q < 16; ++q) bB[q] = *(const GAS bf16x8*)(brow + (lg * 32 + 16 + q) * 512);
        if (lg < 7) CMP_ALOAD(lg + 1);
        const LAS bf16* ab = abuf + (lg & 1) * (ABUF / 2) + r * AROW + 8 * hi;
#pragma unroll
        for (int q = 0; q < 16; ++q) acc = mfma32(*(const LAS bf16x8*)(ab + (q >> 3) * 32 * AROW + (q & 7) * 16), bA[q], acc);
        if (lg < 7) {
#pragma unroll
            for (int q = 0; q < 16; ++q) bA[q] = *(const GAS bf16x8*)(brow + ((lg + 1) * 32 + q) * 512); }
#pragma unroll
        for (int q = 16; q < 32; ++q) acc = mfma32(*(const LAS bf16x8*)(ab + (q >> 3) * 32 * AROW + (q & 7) * 16), bB[q - 16], acc);
        if (lg < 7) CMP_AWRITE(lg + 1, (lg + 1) & 1);
        __syncthreads();
    }
#undef CMP_ALOAD
#undef CMP_AWRITE
    bf16x8 w2f[16];
    if (w < 4) { const GAS bf16* b2 = (const GAS bf16*)W2t + (size_t)(32 * w + r) * 256 + 8 * hi;
#pragma unroll
        for (int q = 0; q < 16; ++q) w2f[q] = *(const GAS bf16x8*)(b2 + 16 * q); }
    __builtin_amdgcn_sched_barrier(0);
#pragma unroll
    for (int rg = 0; rg < 16; ++rg) { const float v = acc[rg]; hidL[crow(rg, hi) * 264 + 32 * w + r] = (bf16)f2bf(v / (1.f + expf(-v))); }
    __syncthreads();
    if (w < 4) {
        f32x16 a2 = {};
#pragma unroll
        for (int q = 0; q < 16; ++q) { const bf16x8 a = *(const LAS bf16x8*)(hidL + r * 264 + 16 * q + 8 * hi); a2 = mfma32(a, w2f[q], a2); }
#pragma unroll
        for (int rg = 0; rg < 16; ++rg) outL[crow(rg, hi) * 132 + 32 * w + r] = a2[rg];
    }
    __syncthreads();
    if (kv == 0) {
        if (F.tid < 256) { const int row = F.tid >> 3, c = F.tid & 7, nn = n0 + row;
            bf16* dst = (bf16*)(ws + WS_KCMP) + ((size_t)(b * 4 + g) * 128 + nn) * 128;
            v4u oa = {0u, 0u, 0u, 0u}, ob = oa;
            float x1[8], x2[8]; float ss = 0.f;
#pragma unroll
            for (int i = 0; i < 8; ++i) { x1[i] = outL[row * 132 + 8 * c + i]; x2[i] = outL[row * 132 + 64 + 8 * c + i]; ss += x1[i] * x1[i] + x2[i] * x2[i]; }
            ss += __shfl_xor(ss, 1); ss += __shfl_xor(ss, 2); ss += __shfl_xor(ss, 4);
            if (nn <= 126) {
                const float rstd = 1.f / sqrtf(ss * (1.f / 128.f) + EPS);
                const float* gamma = inp(F, 12) + j * 384;
                const unsigned* rp = (const unsigned*)(ws + WS_ROPE) + (size_t)(b * T + 16 * nn + 31) * 64 + 8 * c;
                float o1[8], o2[8];
#pragma unroll
                for (int i = 0; i < 8; ++i) { const float y1 = x1[i] * rstd * gamma[8 * c + i], y2 = x2[i] * rstd * gamma[64 + 8 * c + i], co = pg8::f16lo(rp[i]), si = pg8::f16hi(rp[i]);
                    o1[i] = y1 * co - y2 * si; o2[i] = y2 * co + y1 * si; }
                oa.x = pk2(o1[0], o1[1]); oa.y = pk2(o1[2], o1[3]); oa.z = pk2(o1[4], o1[5]); oa.w = pk2(o1[6], o1[7]);
                ob.x = pk2(o2[0], o2[1]); ob.y = pk2(o2[2], o2[3]); ob.z = pk2(o2[4], o2[5]); ob.w = pk2(o2[6], o2[7]);
            }
            *(GAS v4u*)(dst + 8 * c) = oa; *(GAS v4u*)(dst + 64 + 8 * c) = ob; }
    } else {
        const int d = F.tid >> 2, nc = F.tid & 3;
        bf16* dst = (bf16*)(ws + WS_VCMP) + ((size_t)(b * 4 + g) * 128 + d) * 128 + n0 + 8 * nc;
        float v[8];
#pragma unroll
        for (int i = 0; i < 8; ++i) v[i] = (n0 + 8 * nc + i <= 126) ? outL[(8 * nc + i) * 132 + d] : 0.f;
        v4u o; o.x = pk2(v[0], v[1]); o.y = pk2(v[2], v[3]); o.z = pk2(v[4], v[5]); o.w = pk2(v[6], v[7]);
        *(GAS v4u*)dst = o;
    }
    __syncthreads();
}

DEVI void cmpattn_phase(const Ctx& F, unsigned char* ws) {
    const int lane = F.lane, w = F.wave, r = lane & 31, hi = lane >> 5, hl = w >> 1;
    LAS float* SL = (LAS float*)(F.lds);
    LAS bf16* PL = (LAS bf16*)(F.lds + 67584);
    LAS bf16* KL = (LAS bf16*)(F.lds + 102400);
    const bf16* qhm = (const bf16*)(ws + WS_QHM); const bf16* kcmp = (const bf16*)(ws + WS_KCMP); const bf16* vcmp = (const bf16*)(ws + WS_VCMP);
    constexpr float L2E = 1.4426950408889634f;
    for (int grp = F.vcu; grp < 32 * F.NBS; grp += F.G) {
        const int b = F.b0 + (grp >> 5), g = (grp >> 3) & 3, qt0 = (grp & 7) * 8;
        bf16x8 vf[2][8], qf[8];
        __syncthreads();
        { const GAS bf16* kg = (const GAS bf16*)kcmp + (size_t)(b * 4 + g) * 128 * 128;
          const GAS bf16* ksrc = kg + (F.tid >> 4) * 128 + (F.tid & 15) * 8; LAS bf16* kdst = KL + (F.tid >> 4) * 136 + (F.tid & 15) * 8; bf16x8 kt4[4];
#pragma unroll
          for (int c = 0; c < 4; ++c) kt4[c] = *(const GAS bf16x8*)(ksrc + c * 32 * 128);
#pragma unroll
          for (int c = 0; c < 4; ++c) *(LAS bf16x8*)(kdst + c * 32 * 136) = kt4[c]; }
#pragma unroll
        for (int kk = 0; kk < 2; ++kk) { const int t2 = (w & 1) * 2 + kk;
            const GAS bf16* vrow = (const GAS bf16*)vcmp + ((size_t)(b * 4 + g) * 128 + t2 * 32 + r) * 128 + 8 * hi;
#pragma unroll
            for (int d0 = 0; d0 < 8; ++d0) vf[kk][d0] = *(const GAS bf16x8*)(vrow + d0 * 16); }
        __syncthreads();
        const GAS bf16* qbase = (const GAS bf16*)qhm + ((size_t)(b * 16 + g * 4 + hl) * T + r) * 128 + 8 * hi;
#pragma unroll
        for (int d0 = 0; d0 < 8; ++d0) qf[d0] = *(const GAS bf16x8*)(qbase + (size_t)(qt0 * 32) * 128 + d0 * 16);
#pragma unroll 1
        for (int qi8 = 0; qi8 < 8; ++qi8) {
            const int t0 = (qt0 + qi8) * 32;
#pragma unroll
            for (int kk = 0; kk < 2; ++kk) { const int kt = (w & 1) * 2 + kk;
                f32x16 acc = {};
#pragma unroll
                for (int d0 = 0; d0 < 8; ++d0) acc = mfma32(qf[d0], *(const LAS bf16x8*)(KL + (kt * 32 + r) * 136 + d0 * 16 + 8 * hi), acc);
#pragma unroll
                for (int rg = 0; rg < 16; ++rg) SL[(hl * 32 + crow(rg, hi)) * 132 + kt * 32 + r] = acc[rg]; }
            if (qi8 < 7) {
#pragma unroll
                for (int d0 = 0; d0 < 8; ++d0) qf[d0] = *(const GAS bf16x8*)(qbase + (size_t)(t0 + 32) * 128 + d0 * 16); }
            __syncthreads();
            { const int row = F.tid >> 2, part = F.tid & 3, t = t0 + (row & 31), nmax = t >= 31 ? ((t - 31) >> 4) : -1;
              float v[32]; float mx = -__builtin_inff();
#pragma unroll
              for (int i = 0; i < 32; ++i) { const int n = part + 4 * i; const float s = SL[row * 132 + n] * (fa::SCALE * L2E); v[i] = n <= nmax ? s : -__builtin_inff(); mx = fmaxf(mx, v[i]); }
              mx = fmaxf(mx, __shfl_xor(mx, 1)); mx = fmaxf(mx, __shfl_xor(mx, 2));
              float sum = 0.f;
#pragma unroll
              for (int i = 0; i < 32; ++i) { const int n = part + 4 * i; v[i] = n <= nmax ? __builtin_amdgcn_exp2f(v[i] - mx) : 0.f; sum += v[i]; }
              sum += __shfl_xor(sum, 1); sum += __shfl_xor(sum, 2);
              const float inv = sum > 0.f ? 1.f / sum : 0.f;
#pragma unroll
              for (int i = 0; i < 32; ++i) { const int n = part + 4 * i; const float p = v[i] * inv; SL[row * 132 + n] = p; PL[row * 136 + n] = (bf16)f2bf(p); } }
            __syncthreads();
            { const int s = lane & 31, qa = 2 * w + hi;
#pragma unroll
              for (int rep = 0; rep < 2; ++rep) { const int qi = qa + 16 * rep, t = t0 + qi, tb = t >> 6;
                  float imp = 0.f;
#pragma unroll
                  for (int h4 = 0; h4 < 4; ++h4) { const LAS float* p = SL + (h4 * 32 + qi) * 132 + 4 * s;
                      imp += (s > 0 ? p[-1] : 0.f) + 2.f * p[0] + 2.f * p[1] + 2.f * p[2] + p[3]; }
                  const bool forced = (s == 0) || (s == tb) || (s == tb - 1), valid = s <= tb;
                  const float val = forced ? 1e30f : (valid ? imp : -1e30f);
                  int rank = 0;
#pragma unroll
                  for (int s2 = 0; s2 < 32; ++s2) { const float o = __shfl(val, (lane & 32) + s2); rank += (o > val || (o == val && s2 < s)) ? 1 : 0; }
                  const unsigned long long bal = __ballot(rank < 16);
                  if (s == 0) ((unsigned*)(ws + WS_SEL))[(size_t)(b * 4 + g) * T + t] = (unsigned)(bal >> (lane & 32)); } }
            { bf16* ocmp = (bf16*)(ws + WS_O0);
              f32x16 oacc[2];
#pragma unroll
              for (int kk = 0; kk < 2; ++kk) { oacc[kk] = (f32x16){};
#pragma unroll
                  for (int k0 = 0; k0 < 8; ++k0) oacc[kk] = mfma32(*(const LAS bf16x8*)(PL + (hl * 32 + r) * 136 + k0 * 16 + 8 * hi), vf[kk][k0], oacc[kk]); }
              __syncthreads();
              LAS unsigned char* ost = F.lds + w * 4608;
#pragma unroll
              for (int kk = 0; kk < 2; ++kk)
#pragma unroll
                  for (int rg = 0; rg < 16; ++rg) *(LAS bf16*)(ost + crow(rg, hi) * 144 + (kk * 32 + r) * 2) = (bf16)f2bf(oacc[kk][rg]);
              LDS_WAIT();
#pragma unroll
              for (int it = 0; it < 4; ++it) { const int row = it * 8 + (lane >> 3), cb = (lane & 7) * 16;
                  const v4u o4 = *(const LAS v4u*)(ost + row * 144 + cb);
                  *(GAS v4u*)((GAS unsigned char*)(ocmp + (size_t)(b * T + t0 + row) * DM + (g * 4 + hl) * 128 + (w & 1) * 64) + cb) = o4; } }
            __syncthreads();
        }
    }
}

DEVI void gates_finalize(const Ctx& F, unsigned char* ws, int site) {
    const float* gp = (const float*)(ws + WS_GP); const float* ssq = (const float*)(ws + WS_SSQ); const float* shw = (const float*)(ws + WS_SHW); float* gates = (float*)(ws + WS_GATES);
    const int gt = F.gw * 64 + F.lane, GT = F.NGW * 64;
    for (int idx = F.m0 * 12 + gt; idx < (F.m0 + F.MS) * 12; idx += GT) { const int row = idx / 12, c0 = (idx - row * 12) * 4;
        const f32x4 q0 = *(const GAS f32x4*)(ssq + (size_t)row * 8), q1 = *(const GAS f32x4*)(ssq + (size_t)row * 8 + 4);
        const float rs = 1.0f / sqrtf((((q0.x + q0.y) + (q0.z + q0.w)) + ((q1.x + q1.y) + (q1.z + q1.w))) * (1.0f / 2048.0f) + 1e-6f);
        f32x4 pa[4];
#pragma unroll
        for (int kq = 0; kq < 4; ++kq) pa[kq] = *(const GAS f32x4*)(gp + (size_t)kq * ((size_t)M * 48) + (size_t)row * 48 + c0);
        const f32x4 bv = *(const GAS f32x4*)(shw + ((size_t)site * NB + (row >> 11)) * 8192 + 5120 + c0);
        __builtin_amdgcn_sched_barrier(0);
        const f32x4 a = (pa[0] + pa[1]) + (pa[2] + pa[3]);
#pragma unroll
        for (int i = 0; i < 4; ++i) { const int c = c0 + i; gates[((size_t)row * 16 + (c & 15)) * 4 + (c >> 4)] = 1.0f / (1.0f + __expf(-(a[i] * rs + bv[i]))); } }
}
DEVI void nsa_combine(const Ctx& F, unsigned char* ws) {
    const bf16* o0 = (const bf16*)(ws + WS_O0); const bf16* o1 = o0 + (size_t)M * DM; const bf16* o2 = o1 + (size_t)M * DM; const float* gates = (const float*)(ws + WS_GATES); bf16* ao = (bf16*)(ws + WS_AO);
    const int gt = F.gw * 64 + F.lane, GT = F.NGW * 64;
    for (int idx = F.m0 * (DM / 8) + gt; idx < (F.m0 + F.MS) * (DM / 8); idx += GT) { const int m = idx >> 8, col = (idx & 255) * 8, h = col >> 7;
        const f32x4 g4 = *(const GAS f32x4*)(gates + ((size_t)m * 16 + h) * 4); const float g0 = MK_CMPPROBE ? 0.f : g4.x, g1 = g4.y, g2 = g4.z;
        const size_t off = (size_t)m * DM + col;
        const v4u a = *(const GAS v4u*)(o0 + off), bb = *(const GAS v4u*)(o1 + off), cc = *(const GAS v4u*)(o2 + off);
        v4u o;
        o.x = pk2(g0 * bflo(a.x) + g1 * bflo(bb.x) + g2 * bflo(cc.x), g0 * bfhi(a.x) + g1 * bfhi(bb.x) + g2 * bfhi(cc.x));
        o.y = pk2(g0 * bflo(a.y) + g1 * bflo(bb.y) + g2 * bflo(cc.y), g0 * bfhi(a.y) + g1 * bfhi(bb.y) + g2 * bfhi(cc.y));
        o.z = pk2(g0 * bflo(a.z) + g1 * bflo(bb.z) + g2 * bflo(cc.z), g0 * bfhi(a.z) + g1 * bfhi(bb.z) + g2 * bfhi(cc.z));
        o.w = pk2(g0 * bflo(a.w) + g1 * bflo(bb.w) + g2 * bflo(cc.w), g0 * bfhi(a.w) + g1 * bfhi(bb.w) + g2 * bfhi(cc.w));
        *(GAS v4u*)(ao + off) = o; }
}
DEVI void diff_combine(const Ctx& F, unsigned char* ws, int j, int layer) {
    const bf16* oraw = (const bf16*)(ws + WS_O0); bf16* ao = (bf16*)(ws + WS_AO);
    const float* lp = inp(F, 20) + j * 512; const float* sg = inp(F, 21) + j * 256;
    int ly_ = layer; asm volatile("" : "+s"(ly_));
    const float lam_init = ly_ == 1 ? 0.35550906759096934f : 0.5560582041556406f;
    const float s01 = wave_sum(lp[F.lane] * lp[128 + F.lane] + lp[64 + F.lane] * lp[192 + F.lane]);
    const float s23 = wave_sum(lp[256 + F.lane] * lp[384 + F.lane] + lp[320 + F.lane] * lp[448 + F.lane]);
    const float lam = expf(s01) - expf(s23) + lam_init;
    const float osc = 1.f - lam_init;
    const int l5 = F.lane & 31, e0 = l5 * 8;
    const f32x4 ga = *(const GAS f32x4*)(sg + e0), gb = *(const GAS f32x4*)(sg + e0 + 4);
    const int pend = (F.m0 + F.MS) * 4;
#pragma unroll 1
    for (int pp0 = F.m0 * 4 + F.gw; pp0 < pend; pp0 += 4 * F.NGW) {
        v4u a[4], bb[4];
#pragma unroll
        for (int u = 0; u < 4; ++u) { const int pp = pp0 + u * F.NGW; if (pp < pend) { const int mh = pp * 2 + (F.lane >> 5), m = mh >> 3, h = mh & 7;
            a[u] = *(const GAS v4u*)(oraw + (size_t)m * 4096 + (2 * h) * 256 + e0); bb[u] = *(const GAS v4u*)(oraw + (size_t)m * 4096 + (2 * h + 1) * 256 + e0); } }
#pragma unroll
        for (int u = 0; u < 4; ++u) { const int pp = pp0 + u * F.NGW; if (pp < pend) { const int mh = pp * 2 + (F.lane >> 5), m = mh >> 3, h = mh & 7;
            float o[8];
            o[0] = bflo(a[u].x) - lam * bflo(bb[u].x); o[1] = bfhi(a[u].x) - lam * bfhi(bb[u].x); o[2] = bflo(a[u].y) - lam * bflo(bb[u].y); o[3] = bfhi(a[u].y) - lam * bfhi(bb[u].y);
            o[4] = bflo(a[u].z) - lam * bflo(bb[u].z); o[5] = bfhi(a[u].z) - lam * bfhi(bb[u].z); o[6] = bflo(a[u].w) - lam * bflo(bb[u].w); o[7] = bfhi(a[u].w) - lam * bfhi(bb[u].w);
            float ss = 0.f;
#pragma unroll
            for (int i = 0; i < 8; ++i) ss += o[i] * o[i];
            ss += __shfl_xor(ss, 1); ss += __shfl_xor(ss, 2); ss += __shfl_xor(ss, 4); ss += __shfl_xor(ss, 8); ss += __shfl_xor(ss, 16);
            const float rs = osc / sqrtf(ss * (1.f / 256.f) + EPS);
            v4u w; w.x = pk2(o[0] * rs * ga.x, o[1] * rs * ga.y); w.y = pk2(o[2] * rs * ga.z, o[3] * rs * ga.w); w.z = pk2(o[4] * rs * gb.x, o[5] * rs * gb.y); w.w = pk2(o[6] * rs * gb.z, o[7] * rs * gb.w);
            *(GAS v4u*)(ao + (size_t)m * DM + h * 256 + e0) = w; } }
    }
}

typedef fa::BlockRef<bf16, bf16> FaRef;
struct FaItem { const bf16* Q; const bf16* K; const bf16* V; bf16* O; const unsigned* sel; const float* gates; int W, os, qb0, qb1, pk; };
constexpr int FA_BIGW = 1 << 20;
__device__ const unsigned FA_POS[8] = {
    31u | 30u << 8 | 6u << 16 | 0u << 24, 29u | 28u << 8 | 7u << 16 | 1u << 24, 27u | 26u << 8 | 8u << 16 | 2u << 24, 25u | 24u << 8 | 10u << 16 | 3u << 24,
    23u | 22u << 8 | 13u << 16 | 4u << 24, 21u | 20u << 8 | 15u << 16 | 5u << 24, 19u | 18u << 8 | 12u << 16 | 9u << 24, 17u | 16u << 8 | 14u << 16 | 11u << 24 };
DEVI FaItem fa_item(unsigned char* ws, bool nsa, int L, int b0, int nbs) {
    FaItem it; const bf16* qhm = (const bf16*)(ws + WS_QHM); const bf16* ka = (const bf16*)(ws + WS_KA); bf16* o0 = (bf16*)(ws + WS_O0);
    if (nsa) {
        const int per = 32 * nbs, cu = L % per, k = L / per, bgl = cu >> 3, jj = cu & 7, b = b0 + (bgl >> 2), g = bgl & 3, bg = b * 4 + g;
        const int qb = (int)((FA_POS[jj] >> (8 * (k & 3))) & 255u);
        it.Q = qhm + (size_t)(b * 16 + 4 * g) * T * 128; it.os = DM; it.pk = 1; it.qb0 = qb; it.qb1 = qb;
        if (k < 4) {
            it.K = ka + (size_t)bg * T * 128; it.V = ka + (size_t)2 * (8 * MiB) + (size_t)bg * T * 128;
            it.O = o0 + (size_t)M * DM + (size_t)b * T * DM + g * 512; it.sel = MK_NOSEL ? nullptr : (const unsigned*)(ws + WS_SEL) + (size_t)bg * T; it.W = FA_BIGW; it.gates = nullptr; }
        else {
            it.K = ka + (size_t)1 * (8 * MiB) + (size_t)bg * T * 128; it.V = ka + (size_t)3 * (8 * MiB) + (size_t)bg * T * 128; it.sel = nullptr; it.W = MK_WINPROBE ? FA_BIGW : 512;
            if (MK_FUSEC) { it.O = (bf16*)(ws + WS_AO) + (size_t)b * T * DM + g * 512; it.gates = (const float*)(ws + WS_GATES) + ((size_t)b * T * 16 + 4 * g) * 4; }
            else { it.O = o0 + (size_t)2 * M * DM + (size_t)b * T * DM + g * 512; it.gates = nullptr; } }
    } else { const int bhh = L >> 2, x = L & 3, b = b0 + (bhh >> 5), hc = (bhh >> 1) & 15, half = bhh & 1;
        it.Q = qhm + (size_t)(b * 16 + hc) * T * 128; it.K = ka + (size_t)(b * 16 + hc) * T * 128; it.V = (const bf16*)(ws + WS_VA) + (size_t)((b * 8 + (hc >> 1)) * 2 + half) * T * 128;
        it.O = o0 + (size_t)b * T * 4096 + (hc * 2 + half) * 128; it.sel = nullptr; it.W = FA_BIGW; it.os = 4096; it.qb0 = x; it.qb1 = 7 - x; it.pk = 0; it.gates = nullptr; }
    return it;
}
DEVI FaRef fa_ref(const FaItem& it, int pass) {
    const int qb = pass ? it.qb1 : it.qb0, p0 = qb * (it.pk ? 64 : 256); FaRef r;
    r.Q = it.Q + (size_t)p0 * 128; r.K = it.K; r.V = it.V; r.O = it.O + (size_t)p0 * it.os; r.sel = it.sel; r.P0 = p0; r.W = it.W; r.os = it.os; r.pk = it.pk;
    return r;
}
struct FaNext { unsigned char* ws; bool nsa; int L, pass, b0, nbs;
    DEVI FaRef operator()() const { int l = L, p = pass; asm volatile("" : "+s"(l), "+s"(p)); const FaItem it = fa_item(ws, nsa, l, b0, nbs); return fa_ref(it, p); } };
struct FaOut { unsigned char* ws; bool nsa; int L, pass, b0, nbs;
    DEVI fa::OutRef<bf16> operator()() const { int l = L, p = pass; asm volatile("" : "+s"(l), "+s"(p)); const FaItem it = fa_item(ws, nsa, l, b0, nbs); const FaRef r = fa_ref(it, p); fa::OutRef<bf16> o; o.O = r.O; o.os = r.os; o.pk = r.pk; o.gates = it.gates ? it.gates + (size_t)r.P0 * 64 : nullptr; o.dC = (long)WS_O0 - (long)WS_AO; o.dS = o.dC + (long)M * DM * 2; return o; } };
DEVI void flash_phase(const Ctx& F, unsigned char* ws, bool nsa) {
    const int total = nsa ? 256 * F.NBS : 128 * F.NBS, stride = F.G;
    int L = F.vcu; if (L >= total) return;
    int pass = 0;
    fa::Seam<bf16> S;
    { const FaItem it = fa_item(ws, nsa, L, F.b0, F.NBS); const FaRef cur = fa_ref(it, 0); fa::causal_swa_prime<bf16, bf16>(cur, F.ldsg, S, F.wave); }
    for (;;) {
        const FaItem it = fa_item(ws, nsa, L, F.b0, F.NBS); const FaRef cur = fa_ref(it, pass);
        const bool more_pass = pass == 0 && it.qb1 != it.qb0, more_item = L + stride < total, last = !more_pass && !more_item;
        int Ln = L, passn = pass;
        if (more_pass) passn = 1; else if (more_item) { Ln = L + stride; passn = 0; }
        const FaNext nx{ws, nsa, Ln, passn, F.b0, F.NBS}; const FaOut ox{ws, nsa, L, pass, F.b0, F.NBS};
        fa::causal_swa_block<bf16, bf16, FaNext, FaOut>(cur, nx, ox, T, F.ldsg, S, F.wave);
        if (last) break;
        L = Ln; pass = passn;
    }
}

constexpr int PH_STEP0 = 3, PH_PER_STEP = 6, NPH = PH_STEP0 + 8 * PH_PER_STEP;
struct Args { const float* in[22]; float* out; unsigned char* ws; int ph_lo, ph_hi; };
__global__ void __launch_bounds__(NWAVES * 64, 2) mk_fwd(Args args) {
    extern __shared__ __attribute__((aligned(16))) unsigned char lds[];
    const int wv0 = __builtin_amdgcn_readfirstlane(threadIdx.x >> 6);
    Ctx F;
    int split = 0;
#define MKCTX() do { F.lds = (LAS unsigned char*)lds; F.ldsg = (char*)lds; F.tid = opaque_tid(wv0); F.lane = F.tid & 63; F.wave = __builtin_amdgcn_readfirstlane(F.tid >> 6); \
        F.G = gridDim.x; F.bid = opaque_bid(); F.m0 = 0; F.MS = M; F.b0 = 0; F.NBS = NB; \
        if (split) { const int st_ = F.bid & 7; F.bid >>= 3; F.G >>= 3; F.m0 = st_ * T; F.MS = T; F.b0 = st_; F.NBS = 1; } \
        F.vcu = (F.G % 8 == 0) ? (F.bid % 8) * (F.G / 8) + F.bid / 8 : F.bid; F.gw = F.vcu * NWAVES + F.wave; F.NGW = F.G * NWAVES; } while (0)
    MKCTX();
    unsigned char* ws = args.ws;
    const int lo = args.ph_lo, hi = args.ph_hi;
    const bool use_bar = (MK_N_LAUNCHES == 1) ? true : (hi - lo) > 1;
    volatile LAS unsigned* MISC = (volatile LAS unsigned*)(F.lds + MISC_OFF);
    for (int u = F.tid; u < (LDS_BYTES - LDSCTL_OFF) / 4; u += NWAVES * 64) ((LAS unsigned*)(F.lds + LDSCTL_OFF))[u] = 0u;
    __syncthreads();
    if (F.tid == 0) {
#pragma unroll
        for (int k = 0; k < 22; ++k) ((LAS unsigned long long*)(F.lds + PTR_OFF))[k] = (unsigned long long)args.in[k]; }
    __syncthreads();
    const bool dual = MK_DUAL && (MK_N_LAUNCHES == 1 || (lo == 0 && hi == NPH)) && (gridDim.x % 64) == 0;
    const int stream = dual ? ((int)blockIdx.x & 7) : 0;
    if (use_bar) (void)xcd_barrier_post((unsigned*)(ws + WS_CTL) + CW_BAR, MISC + 8, gridDim.x);
    if (dual) (void)xcd_barrier_post((unsigned*)(ws + WS_CTL) + CW_BAR + (1 + stream) * XCD_BAR_WORDS, MISC + 12, gridDim.x / 8);
#define GRID_SYNC() do { XcdBarrier b_; const int sp_ = split; b_.bar = (unsigned*)(ws + WS_CTL) + CW_BAR + (sp_ ? (1 + stream) * XCD_BAR_WORDS : 0); b_.x = xb_xcc_id(); \
        b_.st = (volatile LAS unsigned*)((LAS unsigned char*)lds + MISC_OFF) + (sp_ ? 12 : 8); b_.G = gridDim.x >> (3 * sp_); xcd_barrier(b_); } while (0)
#if MK_N_LAUNCHES == 1
#define IN(k) true
#else
#define IN(k) (lo <= (k) && (k) < hi)
#endif
#ifndef MK_STAG0
#define MK_STAG0 0
#endif
#ifndef MK_STAG5
#define MK_STAG5 0
#endif
#define STAGGER(ticks) do { if ((ticks) > 0 && (F.vcu & 1)) { const unsigned long long t0_ = __builtin_amdgcn_s_memrealtime(); while (__builtin_amdgcn_s_memrealtime() - t0_ < (unsigned long long)(ticks)) __builtin_amdgcn_s_sleep(8); } } while (0)
#ifndef MK_DBLBAR
#define MK_DBLBAR 0
#endif
#ifndef MK_IDLEPROBE
#define MK_IDLEPROBE 0
#endif
#define IDLE_SEL(k) (MK_IDLEPROBE == 1 || (MK_IDLEPROBE == 2 && (k) >= PH_STEP0 && (((k) - PH_STEP0) % PH_PER_STEP == 0 || ((k) - PH_STEP0) % PH_PER_STEP == 5)) || (MK_IDLEPROBE == 3 && (k) >= PH_STEP0 && ((k) - PH_STEP0) % PH_PER_STEP == 3))
#define SEAM(k) do { if (use_bar && IN((k) + 1)) { const bool pr_ = MK_IDLEPROBE && IDLE_SEL(k); if (pr_ && opaque_tid(wv0) == 0) ((volatile LAS unsigned*)((LAS unsigned char*)lds + MISC_OFF))[17] = (unsigned)__builtin_amdgcn_s_memrealtime(); GRID_SYNC(); if (pr_ && opaque_tid(wv0) == 0) { volatile LAS unsigned* q_ = (volatile LAS unsigned*)((LAS unsigned char*)lds + MISC_OFF); q_[16] += (unsigned)__builtin_amdgcn_s_memrealtime() - q_[17]; } if (MK_DBLBAR) GRID_SYNC(); } } while (0)

    if (IN(0)) { MKCTX(); for (int rp = 0; rp < REPN(0); ++rp) { if (EN(0)) p0_prologue(F, ws, 0); __syncthreads(); } SEAM(0); }
    if (IN(1)) { MKCTX(); p1_mod(F, ws); SEAM(1); }
    if (IN(2)) { MKCTX(); for (int rp = 0; rp < REPN(9); ++rp) p2_first(F, ws); SEAM(2); }
    if (dual) split = 1;

    for (int s = 0; s < 8; ++s) {
        const int layer = s >> 1, half = s & 1, j = layer >> 1, pb = PH_STEP0 + s * PH_PER_STEP;
        const bool nsa = (layer & 1) == 0;
        const int nhf = (MK_HSPLIT && use_bar) ? half + 1 : 1;
        for (int hf = 0; hf < nhf; ++hf) {
        if (IN(pb + 0)) { MKCTX();
            const int rn = F.MS / nhf, r0 = F.m0 + hf * rn, hrow0 = nhf == 2 ? (F.m0 >> 1) : r0;
            pg8::Gemm g; g.A = (const bf16*)(ws + WS_H) + (size_t)r0 * DM; g.M = rn; g.K = DM; g.ld = DM;
            if (half == 0) {
                pg8::EpiQKV E; E.ws = ws; E.lds = F.lds; E.site = s; E.j = j; E.nsa = nsa ? 1 : 0; E.m0 = F.m0; E.b0 = F.b0;
                if (nsa) { g.Bt = (const bf16*)(ws + WS_NWIN) + (size_t)j * NSA_INP * DM; g.N = NSA_INP - 256; } else { g.Bt = (const bf16*)(ws + WS_DWIN) + (size_t)j * DIFF_IN * DM; g.N = DIFF_IN; }
                pg8::StaticOrder S; S.init(g.M, g.N, F.G, F.bid);
                STAGGER(MK_STAG0);
                for (int rp = 0; rp < REPN(1); ++rp) { if (EN(1)) pg8::gemm_phase<pg8::EpiQKV, pg8::StaticOrder, true, MK_SP2A>(F.lds, g, S, E, F.wave); __syncthreads(); }
                if (nsa) { pg8::EpiGatesP EG; EG.ws = ws; EG.m0 = F.m0; pg8::Gemm g2 = g; g2.K = DM / 4;
                    pg8::SplitKOrder S2; S2.init(g.M, (NSA_INP - 256) / 256, DM / 4, F.G, F.bid);
                    pg8::gemm_phase<pg8::EpiGatesP, pg8::SplitKOrder, true, MK_SP2A>(F.lds, g2, S2, EG, F.wave); __syncthreads(); }
            } else {
                pg8::EpiStore E; E.ws = ws; E.lds = F.lds; E.site = s; E.m0 = r0; E.b0 = F.b0; E.hrow0 = hrow0;
                g.Bt = (const bf16*)(ws + WS_W1T) + (size_t)layer * DFF * DM; g.N = DFF;
                pg8::StaticOrder S; S.init(g.M, g.N, F.G, F.bid);
                STAGGER(MK_STAG0);
                for (int rp = 0; rp < REPN(1); ++rp) {
                    if (MK_NULLEPI && rp + 1 < REPN(1)) { pg8::EpiNull E0; pg8::gemm_phase<pg8::EpiNull, pg8::StaticOrder, true, true>(F.lds, g, S, E0, F.wave); }
                    else if (EN(1)) pg8::gemm_phase<pg8::EpiStore, pg8::StaticOrder, true, MK_SP2A>(F.lds, g, S, E, F.wave);
                    __syncthreads(); }
            }
            SEAM(pb + 0);
        }
        if (half == 0) {
            if (nsa && IN(pb + 1)) { MKCTX();
                gates_finalize(F, ws, s);
                for (int rp = 0; rp < REPN(3); ++rp) { if (EN(3)) for (int u = F.vcu; u < 32 * F.NBS; u += F.G) compress_unit(F, ws, j, u); }
                SEAM(pb + 1);
            }
            if (nsa && IN(pb + 2)) { MKCTX(); for (int rp = 0; rp < REPN(4); ++rp) { if (EN(4)) cmpattn_phase(F, ws); } SEAM(pb + 2); }
            if (IN(pb + 3)) { MKCTX(); for (int rp = 0; rp < REPN(5); ++rp) { if (EN(5)) flash_phase(F, ws, nsa); __syncthreads(); } SEAM(pb + 3); }
            if (IN(pb + 4) && !(MK_FUSEC && nsa)) { MKCTX(); for (int rp = 0; rp < REPN(6); ++rp) { if (EN(6)) { if (nsa) nsa_combine(F, ws); else diff_combine(F, ws, j, layer); } } SEAM(pb + 4); }
        }
        if (IN(pb + 5)) { MKCTX();
            const int rn = F.MS / nhf, r0 = F.m0 + hf * rn, hrow0 = nhf == 2 ? (F.m0 >> 1) : r0;
            pg8::Gemm g;
            g.M = rn; g.N = DM;
            if (half == 0) { g.A = (const bf16*)(ws + WS_AO) + (size_t)r0 * DM; g.K = DM; g.ld = DM; g.Bt = (nsa ? (const bf16*)(ws + WS_NWOUT) : (const bf16*)(ws + WS_DWOUT)) + (size_t)j * DM * DM; }
            else { g.A = (const bf16*)(ws + WS_HID) + (size_t)hrow0 * DFF; g.K = DFF; g.ld = DFF; g.Bt = (const bf16*)(ws + WS_W2T) + (size_t)layer * DM * DFF; }
            pg8::StaticOrder S; S.init(g.M, g.N, F.G, F.bid);
            STAGGER(MK_STAG5);
#define RUN_RESID(FIRST_, EMIT_) do { pg8::EpiResidT<FIRST_, EMIT_> E; E.ws = ws; E.xo = args.out; E.xo2 = args.out; E.lds = F.lds; E.s = s; E.m0 = r0; E.b0 = F.b0; \
                for (int rp = 0; rp < REPN(7); ++rp) { pg8::EpiResidT<FIRST_, EMIT_> E2 = E; if (rp + 1 < REPN(7)) E2.xo2 = (float*)(ws + WS_O0);     \
                    if (MK_NULLEPI && rp + 1 < REPN(7)) { pg8::EpiNull E0; pg8::gemm_phase<pg8::EpiNull, pg8::StaticOrder, true, true>(F.lds, g, S, E0, F.wave); }     \
                    else if (EN(7)) pg8::gemm_phase<pg8::EpiResidT<FIRST_, EMIT_>, pg8::StaticOrder, true, MK_SP2B>(F.lds, g, S, E2, F.wave); \
                    __syncthreads(); } } while (0)
            if (s == 0) RUN_RESID(true, true); else if (s == 7) RUN_RESID(false, false); else RUN_RESID(false, true);
#undef RUN_RESID
            SEAM(pb + 5);
        }
        }
    }
    if (MK_IDLEPROBE) { gu32* acc_ = (gu32*)(ws + WS_CTL) + 24576; if (opaque_tid(wv0) == 0) __hip_atomic_fetch_add(acc_, ((volatile LAS unsigned*)((LAS unsigned char*)lds + MISC_OFF))[16], RLX_AGENT);
        GRID_SYNC();
        if (blockIdx.x == 0 && opaque_tid(wv0) == 0) { const float us = (float)__hip_atomic_load(acc_, RLX_AGENT) * 0.01f / (float)gridDim.x; args.out[0] += 0.1f + us * (1.0f / 5000.0f); } }
#undef IN
#undef SEAM
}

static bool phase_exists(int k) {
    if (k < PH_STEP0) return true;
    const int s = (k - PH_STEP0) / PH_PER_STEP, slot = (k - PH_STEP0) % PH_PER_STEP, layer = s >> 1, half = s & 1;
    (void)s;
    if (slot == 0 || slot == 5) return true;
    if (half == 1) return false;
    if (slot == 1 || slot == 2) return (layer & 1) == 0;
    if (slot == 4) return !(MK_FUSEC && (layer & 1) == 0);
    return true;
}

extern "C" void kernel_launch(void* const* d_in, const int* in_sizes, int n_in, void* d_out, int out_size, void* d_ws, size_t ws_size, hipStream_t stream) {
    static int grid = 0;
    if (grid == 0) {
        if (n_in != 22 || in_sizes[0] != M * DM || out_size != M * DM || ws_size < WS_END) { fprintf(stderr, "kernel_launch: unexpected shapes (n_in %d, in0 %d, out %d, ws %zu; need ws >= %zu); nothing launched\n", n_in, n_in > 0 ? in_sizes[0] : -1, out_size, ws_size, (size_t)WS_END); grid = -1; return; }
        int dev = 0, cus = 0, per_cu = 0;
        if (hipGetDevice(&dev) != hipSuccess || hipDeviceGetAttribute(&cus, hipDeviceAttributeMultiprocessorCount, dev) != hipSuccess) { fprintf(stderr, "kernel_launch: device query failed\n"); grid = -1; return; }
        if (hipFuncSetAttribute((const void*)mk_fwd, hipFuncAttributeMaxDynamicSharedMemorySize, LDS_BYTES) != hipSuccess) { fprintf(stderr, "kernel_launch: hipFuncSetAttribute failed\n"); grid = -1; return; }
        if (hipOccupancyMaxActiveBlocksPerMultiprocessor(&per_cu, (const void*)mk_fwd, NWAVES * 64, LDS_BYTES) != hipSuccess || per_cu < 1)
            fprintf(stderr, "kernel_launch: note: occupancy query reports %d workgroups per CU\n", per_cu);
        (void)hipGetLastError();
        grid = cus;
    }
    if (grid < 0) return;
    if (hipMemsetAsync((char*)d_ws + WS_CTL, 0, CTL_ZERO_BYTES, stream) != hipSuccess) { fprintf(stderr, "kernel_launch: memset failed\n"); return; }
    Args a{};
    for (int i = 0; i < 22; ++i) a.in[i] = (const float*)d_in[i];
    a.out = (float*)d_out; a.ws = (unsigned char*)d_ws;
#if MK_N_LAUNCHES == 1
    a.ph_lo = 0; a.ph_hi = NPH;
    hipLaunchKernelGGL(mk_fwd, dim3(grid), dim3(NWAVES * 64), LDS_BYTES, stream, a);
#else
    for (int k = 0; k < NPH; ++k) { if (!phase_exists(k)) continue; a.ph_lo = k; a.ph_hi = k + 1;
        hipLaunchKernelGGL(mk_fwd, dim3(grid), dim3(NWAVES * 64), LDS_BYTES, stream, a); }
#endif
    const hipError_t le = hipPeekAtLastError();
    if (le != hipSuccess) fprintf(stderr, "kernel_launch: launch failed: %s\n", hipGetErrorName(le));
}
```
